# Optimizing an MI355X kernel written in HIP

```python
import jax
import jax.numpy as jnp
from jax import lax
import numpy as np

D_MODEL = 1024
BATCH = 4
SEQ = 8192
DEPTH = 1

GRID_W = 64
NORM_EPS = 1e-6
ATT_HEADS = 8
ATT_KV_HEADS = 2
ATT_HEAD_DIM = 64
ATT_GROUPS = ATT_HEADS // ATT_KV_HEADS
ATT_WIDTH = ATT_HEADS * ATT_HEAD_DIM
ATT_KV_WIDTH = ATT_KV_HEADS * ATT_HEAD_DIM
Q_BLOCK = 128
ROPE_THETA = 10000.0
ROPE_AXIS_DIM = ATT_HEAD_DIM // 2
ML_HEADS = 4
ML_HEAD_DIM = 128
ML_WIDTH = ML_HEADS * ML_HEAD_DIM
ML_CHUNK = 128
ML_CONV = 3
ML_DIRS = 2
MIX_WIDTH = ATT_WIDTH + ML_WIDTH
IN_SPLITS = (ATT_WIDTH, ATT_KV_WIDTH, ATT_KV_WIDTH, ML_WIDTH, ML_WIDTH, ML_WIDTH, ML_WIDTH,
             ML_DIRS * ML_HEADS, ML_DIRS * ML_HEADS)
IN_WIDTH = sum(IN_SPLITS)
PEER_HEADS = 8
PEER_NKEYS = 128
PEER_EXPERTS = PEER_NKEYS * PEER_NKEYS
PEER_KEY_DIM = 128
PEER_TOPK = 16
PEER_TOKEN_BLOCK = 128

kernel_name = "hymba_gqa_mlstm_peer_encoder"


def rms_norm(x, gain):
    xf = x.astype(jnp.float32)
    y = xf * lax.rsqrt(jnp.mean(xf * xf, axis=-1, keepdims=True) + NORM_EPS)
    return (y * gain.astype(jnp.float32)).astype(x.dtype)


def split_columns(proj):
    parts, start = [], 0
    for width in IN_SPLITS:
        parts.append(proj[..., start:start + width])
        start += width
    return parts


def axial_rope_tables(rows):
    row_ids = jnp.repeat(jnp.arange(rows, dtype=jnp.float32), GRID_W)
    col_ids = jnp.tile(jnp.arange(GRID_W, dtype=jnp.float32), rows)
    inv_freq = ROPE_THETA ** (-jnp.arange(0, ROPE_AXIS_DIM, 2, dtype=jnp.float32) / ROPE_AXIS_DIM)
    ang = jnp.concatenate([row_ids[:, None] * inv_freq, col_ids[:, None] * inv_freq], axis=-1)
    return jnp.cos(ang), jnp.sin(ang)


def apply_axial_rope(t, cos, sin):
    tf = t.astype(jnp.float32).reshape(*t.shape[:-1], ATT_HEAD_DIM // 2, 2)
    c = cos[None, :, None, :]
    s = sin[None, :, None, :]
    t0, t1 = tf[..., 0], tf[..., 1]
    out = jnp.stack([t0 * c - t1 * s, t0 * s + t1 * c], axis=-1)
    return out.reshape(t.shape).astype(t.dtype)


def grid_attention(q, k, v, q_gain, k_gain, cos, sin):
    b, s = q.shape[0], q.shape[1]
    q = apply_axial_rope(rms_norm(q, q_gain), cos, sin)
    k = apply_axial_rope(rms_norm(k, k_gain), cos, sin)
    n_blocks = s // Q_BLOCK
    qb = q.reshape(b, n_blocks, Q_BLOCK, ATT_KV_HEADS, ATT_GROUPS, ATT_HEAD_DIM)
    qb = jnp.moveaxis(qb, 1, 0)
    scale = ATT_HEAD_DIM ** -0.5

    def one_block(q_blk):
        scores = jnp.einsum('bqkgd,bskd->bkgqs', q_blk, k).astype(jnp.float32) * scale
        probs = jax.nn.softmax(scores, axis=-1).astype(v.dtype)
        return jnp.einsum('bkgqs,bskd->bqkgd', probs, v)

    out = lax.map(one_block, qb)
    return jnp.moveaxis(out, 0, 1).reshape(b, s, ATT_WIDTH)


def centred_depthwise_conv(x, w, bias):
    pad = ML_CONV // 2
    y = lax.conv_general_dilated(
        x, w[:, None, :].astype(x.dtype), window_strides=(1,), padding=[(pad, pad)],
        dimension_numbers=('NWC', 'WIO', 'NWC'), feature_group_count=x.shape[-1])
    return y + bias


def mlstm_chunkwise(q, k, v, log_i, log_f):
    b, h, s, d = q.shape
    n_chunks = s // ML_CHUNK

    def to_chunks(a):
        return jnp.moveaxis(a.reshape(b, h, n_chunks, ML_CHUNK, *a.shape[3:]), 2, 0)

    xs = (to_chunks(q), to_chunks(k), to_chunks(v), to_chunks(log_i), to_chunks(log_f))
    lower = jnp.tril(jnp.ones((ML_CHUNK, ML_CHUNK), dtype=bool))

    def step(carry, inp):
        c_state, n_state, m_state = carry
        qj, kj, vj, ij, fj = inp
        qf, kf, vf = qj.astype(jnp.float32), kj.astype(jnp.float32), vj.astype(jnp.float32)
        bcum = jnp.cumsum(fj, axis=-1)
        dmat = bcum[..., :, None] - bcum[..., None, :] + ij[..., None, :]
        dmat = jnp.where(lower, dmat, -jnp.inf)
        inter = bcum + m_state[..., None]
        m_row = jnp.maximum(inter, jnp.max(dmat, axis=-1))
        w_intra = jnp.exp(dmat - m_row[..., None])
        w_inter = jnp.exp(inter - m_row)
        qk = jnp.einsum('bhld,bhsd->bhls', qf, kf) * w_intra
        num = (w_inter[..., None] * jnp.einsum('bhld,bhde->bhle', qf, c_state)
               + jnp.einsum('bhls,bhse->bhle', qk, vf))
        den = w_inter * jnp.einsum('bhld,bhd->bhl', qf, n_state) + jnp.sum(qk, axis=-1)
        h_out = num / jnp.maximum(jnp.abs(den), jnp.exp(-m_row))[..., None]
        b_tot = bcum[..., -1]
        w_src = b_tot[..., None] - bcum + ij
        m_new = jnp.maximum(b_tot + m_state, jnp.max(w_src, axis=-1))
        decay = jnp.exp(b_tot + m_state - m_new)
        w_src = jnp.exp(w_src - m_new[..., None])
        c_new = decay[..., None, None] * c_state + jnp.einsum('bhs,bhsd,bhse->bhde', w_src, kf, vf)
        n_new = decay[..., None] * n_state + jnp.einsum('bhs,bhsd->bhd', w_src, kf)
        return (c_new, n_new, m_new), h_out.astype(qj.dtype)

    init = (jnp.zeros((b, h, d, d), jnp.float32), jnp.zeros((b, h, d), jnp.float32),
            jnp.zeros((b, h), jnp.float32))
    _, hs = lax.scan(step, init, xs)
    return jnp.moveaxis(hs, 0, 2).reshape(b, h, s, d)


def mlstm_mixer(q, k, v, o, gi, gf, conv_w, conv_b, i_bias, f_bias, out_gain):
    b, s, _ = q.shape
    qk = jax.nn.silu(centred_depthwise_conv(jnp.concatenate([q, k], axis=-1), conv_w, conv_b))
    q, k = qk[..., :ML_WIDTH], qk[..., ML_WIDTH:]

    def heads(a):
        return a.reshape(b, s, ML_HEADS, ML_HEAD_DIM).transpose(0, 2, 1, 3)

    qh, kh, vh = heads(q), heads(k) * (ML_HEAD_DIM ** -0.5), heads(v)
    log_i = (gi.reshape(b, s, ML_DIRS, ML_HEADS) + i_bias).astype(jnp.float32)
    log_f = jax.nn.log_sigmoid((gf.reshape(b, s, ML_DIRS, ML_HEADS) + f_bias).astype(jnp.float32))
    log_i = jnp.transpose(log_i, (2, 0, 3, 1))
    log_f = jnp.transpose(log_f, (2, 0, 3, 1))
    h_fwd = mlstm_chunkwise(qh, kh, vh, log_i[0], log_f[0])
    rev = lambda a: jnp.flip(a, axis=2)
    h_bwd = rev(mlstm_chunkwise(rev(qh), rev(kh), rev(vh), rev(log_i[1]), rev(log_f[1])))
    hsum = (h_fwd + h_bwd).transpose(0, 2, 1, 3)
    hsum = rms_norm(hsum, out_gain).reshape(b, s, ML_WIDTH)
    return jax.nn.sigmoid(o) * hsum


def peer_ffn(xn, w_query, sub_keys, expert_down, expert_up):
    b, s, dm = xn.shape
    t = b * s
    xt = xn.reshape(t, dm)
    qh = (xt @ w_query).reshape(t, PEER_HEADS, 2, PEER_KEY_DIM)
    half_scores = jnp.einsum('thpd,hpnd->thpn', qh, sub_keys).astype(jnp.float32)
    v_half, i_half = lax.top_k(half_scores, PEER_TOPK)
    cand_score = (v_half[:, :, 0, :, None] + v_half[:, :, 1, None, :]).reshape(t, PEER_HEADS, PEER_TOPK * PEER_TOPK)
    cand_id = (i_half[:, :, 0, :, None] * PEER_NKEYS + i_half[:, :, 1, None, :]).reshape(t, PEER_HEADS, PEER_TOPK * PEER_TOPK)
    top_score, top_pos = lax.top_k(cand_score, PEER_TOPK)
    expert_ids = jnp.take_along_axis(cand_id, top_pos, axis=-1)
    gates = jax.nn.softmax(top_score, axis=-1).astype(xn.dtype)
    n_blocks = t // PEER_TOKEN_BLOCK

    def one_block(args):
        x_blk, id_blk, g_blk = args
        act = jax.nn.gelu(jnp.einsum('td,thkd->thk', x_blk, expert_down[id_blk]), approximate=False)
        return jnp.einsum('thk,thkd->td', g_blk * act, expert_up[id_blk])

    out = lax.map(one_block, (xt.reshape(n_blocks, PEER_TOKEN_BLOCK, dm),
                              expert_ids.reshape(n_blocks, PEER_TOKEN_BLOCK, PEER_HEADS, PEER_TOPK),
                              gates.reshape(n_blocks, PEER_TOKEN_BLOCK, PEER_HEADS, PEER_TOPK)))
    return out.reshape(b, s, dm)


def setup_inputs(seed: int = 0) -> dict:
    key = jax.random.key(seed)
    ks = jax.random.split(key, 16)
    f32 = jnp.float32
    nrm = lambda k, shape, scale: jax.random.normal(k, shape, f32) * scale
    gain = lambda k, shape: 1.0 + 0.02 * jax.random.normal(k, shape, f32)
    f_bias = jnp.linspace(3.0, 6.0, ML_HEADS, dtype=f32)[None, None, :] + nrm(ks[8], (DEPTH, ML_DIRS, ML_HEADS), 0.1)
    return {
        "x": nrm(ks[0], (BATCH, SEQ, D_MODEL), 1.0),
        "norm1_gain": gain(ks[1], (DEPTH, D_MODEL)),
        "w_in": nrm(ks[2], (DEPTH, D_MODEL, IN_WIDTH), D_MODEL ** -0.5),
        "att_q_gain": gain(ks[3], (DEPTH, ATT_HEAD_DIM)),
        "att_k_gain": gain(ks[4], (DEPTH, ATT_HEAD_DIM)),
        "ml_conv_w": nrm(ks[5], (DEPTH, ML_CONV, 2 * ML_WIDTH), ML_CONV ** -0.5),
        "ml_conv_b": nrm(ks[6], (DEPTH, 2 * ML_WIDTH), 0.02),
        "ml_igate_bias": nrm(ks[7], (DEPTH, ML_DIRS, ML_HEADS), 0.1),
        "ml_fgate_bias": f_bias,
        "ml_out_gain": gain(ks[9], (DEPTH, ML_HEADS, ML_HEAD_DIM)),
        "w_out": nrm(ks[10], (DEPTH, MIX_WIDTH, D_MODEL), MIX_WIDTH ** -0.5),
        "norm2_gain": gain(ks[11], (DEPTH, D_MODEL)),
        "peer_w_query": nrm(ks[12], (DEPTH, D_MODEL, PEER_HEADS * 2 * PEER_KEY_DIM), D_MODEL ** -0.5),
        "peer_sub_keys": nrm(ks[13], (DEPTH, PEER_HEADS, 2, PEER_NKEYS, PEER_KEY_DIM), PEER_KEY_DIM ** -0.5),
        "peer_down": nrm(ks[14], (DEPTH, PEER_EXPERTS, D_MODEL), D_MODEL ** -0.5),
        "peer_up": nrm(ks[15], (DEPTH, PEER_EXPERTS, D_MODEL), PEER_HEADS ** -0.5),
    }


def reference(x, norm1_gain, w_in, att_q_gain, att_k_gain, ml_conv_w, ml_conv_b, ml_igate_bias,
              ml_fgate_bias, ml_out_gain, w_out, norm2_gain, peer_w_query, peer_sub_keys, peer_down, peer_up):
    b, s, _ = x.shape
    rows = s // GRID_W
    cos, sin = axial_rope_tables(rows)
    h = x
    for layer in range(DEPTH):
        hn = rms_norm(h, norm1_gain[layer])
        proj = hn @ w_in[layer]
        aq, ak, av, mq, mk, mv, mo, mi, mf = split_columns(proj)
        att = grid_attention(aq.reshape(b, s, ATT_HEADS, ATT_HEAD_DIM),
                             ak.reshape(b, s, ATT_KV_HEADS, ATT_HEAD_DIM),
                             av.reshape(b, s, ATT_KV_HEADS, ATT_HEAD_DIM),
                             att_q_gain[layer], att_k_gain[layer], cos, sin)
        mem = mlstm_mixer(mq, mk, mv, mo, mi, mf, ml_conv_w[layer], ml_conv_b[layer],
                          ml_igate_bias[layer], ml_fgate_bias[layer], ml_out_gain[layer])
        h = h + jnp.concatenate([att, mem], axis=-1) @ w_out[layer]
        hn2 = rms_norm(h, norm2_gain[layer])
        h = h + peer_ffn(hn2, peer_w_query[layer], peer_sub_keys[layer], peer_down[layer], peer_up[layer])
    return h
```

```cpp
#include <hip/hip_runtime.h>
#include <cstdio>
#include <cstdint>
namespace pg8 {
#define PG8_LAS __attribute__((address_space(3)))
typedef unsigned short bf16_t;
typedef short bf16x8 __attribute__((ext_vector_type(8)));
typedef float f32x4 __attribute__((ext_vector_type(4)));
typedef unsigned u32x4 __attribute__((ext_vector_type(4)));
typedef int v8i32 __attribute__((ext_vector_type(8)));
constexpr int BM = 256, BK = 64, HALF = 128, HTB = HALF * BK * 2  , STAGE_BYTES = 8 * HTB, NXCD = 8, WGM = 8;

__host__ __device__ __forceinline__ int lds_byte(int r, int c) { const int st = (r >> 4) * 2 + (c >> 5), rr = r & 15, cc = c & 31, ob = rr * 64 + cc * 2; return st * 1024 + (ob ^ (((ob >> 9) & 1) << 5)); }
__host__ __device__ __forceinline__ void stage_rc(int b, int& R, int& C) { const int st = b / 1024, sb = b % 1024, swz = sb ^ (((sb >> 9) & 1) << 5); R = (st >> 1) * 16 + swz / 64; C = (st & 1) * 32 + (swz % 64) / 2; }
__host__ __device__ __forceinline__ int perm32(int rho) { const int n = rho >> 4, i = rho & 15; return 8 * (i >> 2) + 4 * n + (i & 3); }

struct Unit { int pm, pn; };
struct Gemm { const bf16_t* A; const bf16_t* Bt; int M, N, K; };

struct StaticOrder {
    int nM, nN, nwg, G, c;
    __host__ __device__ void init(int M, int N, int G_, int c_) { nM = M / BM; nN = N / BM; nwg = nM * nN; G = G_; c = c_; }
    __host__ __device__ bool next(int i, Unit& u) const {
        const long L = (long)i * G + c; if (L >= nwg) return false;
        int wgid = (int)L; { const int q = nwg / NXCD, r = nwg % NXCD, xcd = wgid % NXCD, off = wgid / NXCD; wgid = (xcd < r ? xcd * (q + 1) : r * (q + 1) + (xcd - r) * q) + off; }
        const int nig = WGM * nN, gid = wgid / nig, fm = gid * WGM, gsz = (nM - fm) < WGM ? (nM - fm) : WGM;
        u.pm = fm + ((wgid % nig) % gsz); u.pn = (wgid % nig) / gsz; return true;
    }
    __device__ __forceinline__ void a_ready(const Unit&) const {}
    __device__ __forceinline__ void done(const Unit&) const {}
};


__device__ __forceinline__ unsigned cvt_pk_bf16(float lo, float hi) { unsigned r; asm volatile("v_cvt_pk_bf16_f32 %0, %1, %2" : "=v"(r) : "v"(lo), "v"(hi)); return r; }
typedef float f32x2 __attribute__((ext_vector_type(2)));

struct EpiProj {
    static constexpr bool PERM = true, AFTER_DRAIN = false;
    bf16_t *AQ, *AK, *AV, *MQ, *MK, *MV, *MO; const float* SA; const unsigned* WMAX;
    __device__ __forceinline__ void operator()(const f32x4 (&acc)[2][2][4][2], const Unit& u, int wr, int wc, int fr, int fq) const {
        const int row0 = u.pm * BM + wr * 64 + fr;
        const float sw = __builtin_bit_cast(float, __hip_atomic_load(const_cast<unsigned*>(WMAX), __ATOMIC_RELAXED, __HIP_MEMORY_SCOPE_AGENT)) * (1.0f / 127.0f);
        float rsc[2][4];
#pragma unroll
        for (int ai = 0; ai < 2; ++ai)
#pragma unroll
            for (int m = 0; m < 4; ++m) rsc[ai][m] = SA[row0 + ai * HALF + m * 16] * sw;
#pragma unroll
        for (int bj = 0; bj < 2; ++bj) {
            const int colt = u.pn * BM + bj * HALF;
            bf16_t* base; int ld, c0;
            if (colt < 512)       { base = AQ; ld = 512; c0 = colt; }
            else if (colt < 640)  { base = AK; ld = 128; c0 = colt - 512; }
            else if (colt < 768)  { base = AV; ld = 128; c0 = colt - 640; }
            else if (colt < 1280) { base = MQ; ld = 512; c0 = colt - 768; }
            else if (colt < 1792) { base = MK; ld = 512; c0 = colt - 1280; }
            else if (colt < 2304) { base = MV; ld = 512; c0 = colt - 1792; }
            else                  { base = MO; ld = 512; c0 = colt - 2304; }
            const int col0 = c0 + wc * 32 + 8 * fq;
#pragma unroll
            for (int ai = 0; ai < 2; ++ai)
#pragma unroll
                for (int m = 0; m < 4; ++m) {
                    const f32x4 v0 = acc[ai][bj][m][0] * rsc[ai][m], v1 = acc[ai][bj][m][1] * rsc[ai][m];
                    u32x4 w; w.x = cvt_pk_bf16(v0[0], v0[1]); w.y = cvt_pk_bf16(v0[2], v0[3]); w.z = cvt_pk_bf16(v1[0], v1[1]); w.w = cvt_pk_bf16(v1[2], v1[3]);
                    *(u32x4*)(base + (size_t)(row0 + ai * HALF + m * 16) * ld + col0) = w;
                }
        }
    }
};

struct EpiRes {
    static constexpr bool PERM = false, AFTER_DRAIN = false;
    const unsigned char* XA8; const float* SA; const float* RR; bf16_t* HB; float* SSQ; float sc;
    __device__ __forceinline__ void operator()(const f32x4 (&acc)[2][2][4][2], const Unit& u, int wr, int wc, int fr, int fq) const {
        const int col0 = u.pn * BM + wc * 32 + 4 * fq;
        typedef unsigned u32x2v __attribute__((ext_vector_type(2)));
#pragma unroll
        for (int ai = 0; ai < 2; ++ai) {
            unsigned xw[4][2][2]; float rrv[4];
#pragma unroll
            for (int m = 0; m < 4; ++m) { const int row = u.pm * BM + ai * HALF + wr * 64 + m * 16 + fr; const size_t off = (size_t)row * 1024 + col0; rrv[m] = RR[row] * SA[row];
#pragma unroll
                for (int bj = 0; bj < 2; ++bj)
#pragma unroll
                    for (int n = 0; n < 2; ++n) xw[m][bj][n] = *(const unsigned*)(XA8 + off + bj * HALF + n * 16); }
#pragma unroll
            for (int m = 0; m < 4; ++m) {
                const int row = u.pm * BM + ai * HALF + wr * 64 + m * 16 + fr;
                const size_t off = (size_t)row * 1024 + col0;
                float ss = 0.f;
#pragma unroll
                for (int bj = 0; bj < 2; ++bj)
#pragma unroll
                    for (int n = 0; n < 2; ++n) {
                        const int xq = (int)xw[m][bj][n];
                        const f32x4 xv = {(float)((xq << 24) >> 24), (float)((xq << 16) >> 24), (float)((xq << 8) >> 24), (float)(xq >> 24)};
                        const f32x4 hv = xv * rrv[m] + acc[ai][bj][m][n] * sc;
                        u32x2v w; w.x = cvt_pk_bf16(hv[0], hv[1]); w.y = cvt_pk_bf16(hv[2], hv[3]);
                        *(u32x2v*)(HB + off + bj * HALF + n * 16) = w;
                        ss += (hv[0] * hv[0] + hv[1] * hv[1]) + (hv[2] * hv[2] + hv[3] * hv[3]);
                    }
                ss += __shfl_xor(ss, 16); ss += __shfl_xor(ss, 32);
                if (fq == 0) SSQ[(size_t)row * 16 + u.pn * 4 + wc] = ss;
            }
        }
    }
};

struct EpiScore {
    static constexpr bool PERM = true, AFTER_DRAIN = false;
    const float* SSQ; unsigned short* SC; float eps;
    __device__ __forceinline__ void operator()(const f32x4 (&acc)[2][2][4][2], const Unit& u, int wr, int wc, int fr, int fq) const {
        const int row0 = u.pm * BM + wr * 64 + fr;
#pragma unroll
        for (int ai = 0; ai < 2; ++ai)
#pragma unroll
            for (int m = 0; m < 4; ++m) {
                const int row = row0 + ai * HALF + m * 16;
#pragma unroll
                for (int bj = 0; bj < 2; ++bj) {
                    const f32x4 v0 = acc[ai][bj][m][0], v1 = acc[ai][bj][m][1];
                    typedef _Float16 h2 __attribute__((ext_vector_type(2)));
                    u32x4 w;
                    { h2 t = {(_Float16)v0[0], (_Float16)v0[1]}; w.x = __builtin_bit_cast(unsigned, t); }
                    { h2 t = {(_Float16)v0[2], (_Float16)v0[3]}; w.y = __builtin_bit_cast(unsigned, t); }
                    { h2 t = {(_Float16)v1[0], (_Float16)v1[1]}; w.z = __builtin_bit_cast(unsigned, t); }
                    { h2 t = {(_Float16)v1[2], (_Float16)v1[3]}; w.w = __builtin_bit_cast(unsigned, t); }
                    w.x ^= (((w.x >> 15) & 0x00010001u) * 0x7fffu) | 0x80008000u; w.y ^= (((w.y >> 15) & 0x00010001u) * 0x7fffu) | 0x80008000u;
                    w.z ^= (((w.z >> 15) & 0x00010001u) * 0x7fffu) | 0x80008000u; w.w ^= (((w.w >> 15) & 0x00010001u) * 0x7fffu) | 0x80008000u;
                    *(u32x4*)(SC + ((((size_t)(row >> 6) * 16 + (u.pn * 2 + bj)) * 16 + (wc * 4 + fq)) * 64 + (row & 63)) * 8) = w;
                }
            }
    }
};

template <class Epi, class Sched, bool ALIGN_EPI = false, bool SP2 = false, bool F8 = false, bool I8 = false>
__device__ __forceinline__ void gemm_phase(PG8_LAS unsigned char* lds, const Gemm g, const Sched& S, const Epi& E) {
    int tid_ = threadIdx.x; asm volatile("" : "+v"(tid_));
    const int tid = tid_, wid = __builtin_amdgcn_readfirstlane(tid >> 6), lane = tid & 63, wr = wid >> 2, wc = wid & 3, fr = lane & 15, fq = lane >> 4;
    const int K = g.K, nt = K / BK;
    unsigned voffA[2], voffB[2];
#pragma unroll
    for (int i = 0; i < 2; ++i) { int R, C; stage_rc(tid * 16 + i * 8192, R, C); const int Rb = Epi::PERM ? ((R & ~31) + perm32(R & 31)) : R;
        voffA[i] = (unsigned)(R * K + C) * 2u; voffB[i] = (unsigned)(Rb * K + C) * 2u; }
    const size_t kstep = (size_t)(BK * 2);
    const size_t hstep = (size_t)HALF * K * 2;
    const size_t tstep = 2 * hstep;
    const unsigned ldsw = (unsigned)wid * 1024u;
    const int aoff = lds_byte(wr * 64 + fr, fq * 8), boff = lds_byte(wc * 32 + fr, fq * 8);
#define PG8_SA(b, h) (((b) * 2 + (h)) * HTB)
#define PG8_SB(b, h) ((4 + (b) * 2 + (h)) * HTB)
#define PG8_STAGE(bufoff, gbase, voff) do { _Pragma("unroll") for (int _i = 0; _i < 2; ++_i) \
        __builtin_amdgcn_global_load_lds((const unsigned*)((const char*)(gbase) + (voff)[_i]), (PG8_LAS unsigned*)(lds + (bufoff) + ldsw + _i * 8192), 16, 0, 0); } while (0)
#define PG8_LD8(p) ({ const u32x4 lo_ = *(const PG8_LAS u32x4*)(p), hi_ = *(const PG8_LAS u32x4*)((p) + 1024); (v8i32){(int)lo_.x, (int)lo_.y, (int)lo_.z, (int)lo_.w, (int)hi_.x, (int)hi_.y, (int)hi_.z, (int)hi_.w}; })
#define PG8_LDA(dst, b, h) do { _Pragma("unroll") for (int m = 0; m < 4; ++m) { if constexpr (F8) dst##8[m] = PG8_LD8(lds + PG8_SA(b, h) + aoff + m * 2048); else { _Pragma("unroll") for (int k = 0; k < 2; ++k) dst[m][k] = *(const PG8_LAS bf16x8*)(lds + PG8_SA(b, h) + aoff + m * 2048 + k * 1024); } } } while (0)
#define PG8_LDB(dst, b, h) do { _Pragma("unroll") for (int n = 0; n < 2; ++n) { if constexpr (F8) dst##8[n] = PG8_LD8(lds + PG8_SB(b, h) + boff + n * 2048); else { _Pragma("unroll") for (int k = 0; k < 2; ++k) dst[n][k] = *(const PG8_LAS bf16x8*)(lds + PG8_SB(b, h) + boff + n * 2048 + k * 1024); } } } while (0)
#define PG8_MMA(ai, bj, At, Bt) do { __builtin_amdgcn_s_setprio(1); \
        if constexpr (I8) { _Pragma("unroll") for (int k = 0; k < 2; ++k) _Pragma("unroll") for (int m = 0; m < 4; ++m) _Pragma("unroll") for (int n = 0; n < 2; ++n)   \
            asm volatile("v_mfma_i32_16x16x64_i8 %0, %1, %2, %0" : "+v"(acc[ai][bj][m][n]) : "v"(Bt[n][k]), "v"(At[m][k])); } \
        else { _Pragma("unroll") for (int m = 0; m < 4; ++m) _Pragma("unroll") for (int n = 0; n < 2; ++n) { \
        if constexpr (F8) asm volatile("v_mfma_f32_16x16x128_f8f6f4 %0, %1, %2, %0" : "+v"(acc[ai][bj][m][n]) : "v"(Bt##8[n]), "v"(At##8[m]));   \
        else { _Pragma("unroll") for (int k = 0; k < 2; ++k) acc[ai][bj][m][n] = __builtin_amdgcn_mfma_f32_16x16x32_bf16(Bt[n][k], At[m][k], acc[ai][bj][m][n], 0, 0, 0); } } } __builtin_amdgcn_s_setprio(0); } while (0)
#define PG8_WAIT_V(n) asm volatile("s_waitcnt vmcnt(" #n ")" ::: "memory")
#define PG8_WAIT_L(n) asm volatile("s_waitcnt lgkmcnt(" #n ")" ::: "memory")
#define PG8_BAR __builtin_amdgcn_s_barrier()
#define PG8_SCHED __builtin_amdgcn_sched_barrier(0)
    Unit cur, nxt; int ui = 0;
    if (!S.next(0, cur)) return;
    f32x4 acc[2][2][4][2];
#pragma unroll
    for (int a = 0; a < 2; ++a)
#pragma unroll
        for (int b = 0; b < 2; ++b)
#pragma unroll
            for (int m = 0; m < 4; ++m)
#pragma unroll
                for (int n = 0; n < 2; ++n) acc[a][b][m][n] = (f32x4){0.f, 0.f, 0.f, 0.f};
    bf16x8 At[4][2], B0[2][2], B1[2][2]; v8i32 At8[4], B08[2], B18[2];
    const char* cA = (const char*)g.A + (size_t)cur.pm * tstep; const char* cB = (const char*)g.Bt + (size_t)cur.pn * tstep;
    S.a_ready(cur);
    if constexpr (SP2) {
        PG8_STAGE(PG8_SB(0, 0), cB, voffB); PG8_STAGE(PG8_SB(0, 1), cB + hstep, voffB); PG8_STAGE(PG8_SA(0, 0), cA, voffA); PG8_STAGE(PG8_SA(0, 1), cA + hstep, voffA);
        if (wr == 1) PG8_BAR;
        PG8_WAIT_V(2); PG8_BAR;
        PG8_STAGE(PG8_SB(1, 0), cB + kstep, voffB); PG8_STAGE(PG8_SA(1, 0), cA + kstep, voffA); PG8_STAGE(PG8_SB(1, 1), cB + hstep + kstep, voffB);
        PG8_WAIT_V(6); PG8_BAR;
    } else {
        PG8_STAGE(PG8_SB(0, 0), cB, voffB); PG8_STAGE(PG8_SA(0, 0), cA, voffA); PG8_STAGE(PG8_SB(0, 1), cB + hstep, voffB); PG8_STAGE(PG8_SA(0, 1), cA + hstep, voffA);
        if (wr == 1) PG8_BAR;
        PG8_WAIT_V(4); PG8_BAR;
        PG8_STAGE(PG8_SB(1, 0), cB + kstep, voffB); PG8_STAGE(PG8_SA(1, 0), cA + kstep, voffA); PG8_STAGE(PG8_SB(1, 1), cB + hstep + kstep, voffB);
        PG8_WAIT_V(6); PG8_BAR;
    }
    for (;;) {
        const bool has_next = S.next(ui + 1, nxt);
        const char* nA = has_next ? (const char*)g.A + (size_t)nxt.pm * tstep : cA; const char* nB = has_next ? (const char*)g.Bt + (size_t)nxt.pn * tstep : cB;
        for (int t = 0; t < nt; t += 2) {
            const bool last = (t == nt - 2);
            const char* a1 = cA + (size_t)(t + 1) * kstep;
            const char* a2 = last ? nA : cA + (size_t)(t + 2) * kstep; const char* b2 = last ? nB : cB + (size_t)(t + 2) * kstep;
            const char* a3 = a2 + kstep; const char* b3 = b2 + kstep;
            if (last && has_next) S.a_ready(nxt);
            if constexpr (SP2) {
            PG8_LDB(B0, 0, 0); PG8_LDB(B1, 0, 1); PG8_SCHED; PG8_LDA(At, 0, 0); PG8_STAGE(PG8_SA(1, 1), a1 + hstep, voffA);
            PG8_WAIT_V(8); PG8_WAIT_L(0); PG8_BAR; PG8_MMA(0, 0, At, B0); PG8_MMA(0, 1, At, B1); PG8_BAR; PG8_SCHED;
            PG8_LDA(At, 0, 1); PG8_STAGE(PG8_SB(0, 0), b2, voffB); PG8_STAGE(PG8_SB(0, 1), b2 + hstep, voffB); PG8_STAGE(PG8_SA(0, 0), a2, voffA);
            PG8_WAIT_V(8); PG8_WAIT_L(0); PG8_BAR; PG8_MMA(1, 0, At, B0); PG8_MMA(1, 1, At, B1); PG8_BAR; PG8_SCHED;
            PG8_LDB(B0, 1, 0); PG8_LDB(B1, 1, 1); PG8_SCHED; PG8_LDA(At, 1, 0); PG8_STAGE(PG8_SA(0, 1), a2 + hstep, voffA);
            PG8_WAIT_V(8); PG8_WAIT_L(0); PG8_BAR; PG8_MMA(0, 0, At, B0); PG8_MMA(0, 1, At, B1); PG8_BAR; PG8_SCHED;
            PG8_LDA(At, 1, 1); PG8_STAGE(PG8_SB(1, 0), b3, voffB); PG8_STAGE(PG8_SB(1, 1), b3 + hstep, voffB); PG8_STAGE(PG8_SA(1, 0), a3, voffA);
            PG8_WAIT_V(8); PG8_WAIT_L(0); PG8_BAR; PG8_MMA(1, 0, At, B0); PG8_MMA(1, 1, At, B1); PG8_BAR; PG8_SCHED;
            } else {
            PG8_LDB(B0, 0, 0); PG8_SCHED; PG8_LDA(At, 0, 0); PG8_STAGE(PG8_SA(1, 1), a1 + hstep, voffA);
            PG8_WAIT_L(8); PG8_BAR; PG8_WAIT_L(0); PG8_MMA(0, 0, At, B0); PG8_BAR; PG8_SCHED;
            PG8_LDB(B1, 0, 1); PG8_STAGE(PG8_SB(0, 0), b2, voffB);
            PG8_BAR; PG8_WAIT_L(0); PG8_MMA(0, 1, At, B1); PG8_BAR;
            PG8_LDA(At, 0, 1); PG8_STAGE(PG8_SA(0, 0), a2, voffA);
            PG8_BAR; PG8_WAIT_L(0); PG8_MMA(1, 0, At, B0); PG8_BAR; PG8_SCHED;
            PG8_STAGE(PG8_SB(0, 1), b2 + hstep, voffB);
            PG8_WAIT_V(6); PG8_BAR; PG8_MMA(1, 1, At, B1); PG8_BAR;
            PG8_LDB(B0, 1, 0); PG8_SCHED; PG8_LDA(At, 1, 0); PG8_STAGE(PG8_SA(0, 1), a2 + hstep, voffA);
            PG8_WAIT_L(8); PG8_BAR; PG8_WAIT_L(0); PG8_MMA(0, 0, At, B0); PG8_BAR; PG8_SCHED;
            PG8_LDB(B1, 1, 1); PG8_STAGE(PG8_SB(1, 0), b3, voffB);
            PG8_BAR; PG8_WAIT_L(0); PG8_MMA(0, 1, At, B1); PG8_BAR;
            PG8_LDA(At, 1, 1); PG8_STAGE(PG8_SA(1, 0), a3, voffA);
            PG8_BAR; PG8_WAIT_L(0); PG8_MMA(1, 0, At, B0); PG8_BAR; PG8_SCHED;
            PG8_STAGE(PG8_SB(1, 1), b3 + hstep, voffB);
            PG8_WAIT_V(6); PG8_BAR; PG8_MMA(1, 1, At, B1); PG8_BAR;
            }
        }
        if constexpr (ALIGN_EPI) { if (wr == 0) PG8_BAR; }
        if constexpr (F8 || I8) asm volatile("s_nop 15\n\ts_nop 7" ::: "memory");
        if constexpr (I8) {
#pragma unroll
            for (int a = 0; a < 2; ++a)
#pragma unroll
                for (int b = 0; b < 2; ++b)
#pragma unroll
                    for (int m = 0; m < 4; ++m)
#pragma unroll
                        for (int n = 0; n < 2; ++n)
#pragma unroll
                            for (int c = 0; c < 4; ++c) { const float t_ = acc[a][b][m][n][c]; acc[a][b][m][n][c] = (float)__float_as_int(t_); }
        }
        if constexpr (!Epi::AFTER_DRAIN) { E(acc, cur, wr, wc, fr, fq); S.done(cur); }
        if (!has_next) break;
#pragma unroll
        for (int a = 0; a < 2; ++a)
#pragma unroll
            for (int b = 0; b < 2; ++b)
#pragma unroll
                for (int m = 0; m < 4; ++m)
#pragma unroll
                    for (int n = 0; n < 2; ++n) acc[a][b][m][n] = (f32x4){0.f, 0.f, 0.f, 0.f};
        cur = nxt; cA = nA; cB = nB; ++ui;
        if constexpr (ALIGN_EPI) { if (wr == 1) PG8_BAR; }
    }
    PG8_WAIT_V(0);
    if constexpr (!ALIGN_EPI) { if (wr == 0) PG8_BAR; }
    PG8_BAR;
    if constexpr (Epi::AFTER_DRAIN) { E.fused(acc, cur, wr, wc, fr, fq, lds, wid, lane); S.done(cur); }
#undef PG8_SA
#undef PG8_SB
#undef PG8_STAGE
#undef PG8_LDA
#undef PG8_LDB
#undef PG8_MMA
#undef PG8_LD8
#undef PG8_WAIT_V
#undef PG8_WAIT_L
#undef PG8_BAR
#undef PG8_SCHED
}
}

#define PG8_SP2 true
#define PG8_ALIGN true
#include <hip/hip_bf16.h>
#include <cmath>
namespace attn_body {
using bf16=__hip_bfloat16;
using bf16x8=__attribute__((ext_vector_type(8)))short;
using s16x4=__attribute__((ext_vector_type(4)))short;
using f32x16=__attribute__((ext_vector_type(16)))float;
using u32x4=__attribute__((ext_vector_type(4)))unsigned;
constexpr int BATCH=4,NHEAD=8,SEQ=8192,D=64;
constexpr int QP=512,KP=128,OP=1024;
constexpr int NW=8,QBLK=32,QB=QBLK*NW,KVBLK=64,NQB=SEQ/QB;
constexpr int ATTN_UNIT_ROWS=QB;
__device__ __forceinline__ int crow(int r,int hi){return (r&3)+8*(r>>2)+4*hi;}
#define SBAR() __builtin_amdgcn_sched_barrier(0)
__device__ __forceinline__ void cmask(f32x16&p0,f32x16&p1,int jb,int qrel,int hi){
  const float NEG=-INFINITY; int kb=64*jb+4*hi;
  #pragma unroll
  for(int r=0;r<16;++r){int kv=kb+(r&3)+8*(r>>2); if(kv>qrel)p0[r]=NEG; if(kv+32>qrel)p1[r]=NEG;}
}

constexpr int NSLOT=3, NVSLOT=4, SLOTB=4096, KSLOTB=4096;
constexpr int LDS_K=0, LDS_V=NSLOT*KSLOTB, LDS_WS=NSLOT*KSLOTB+NVSLOT*SLOTB, LDS_OST=LDS_WS+NW*64*4, LDS_BYTES=LDS_OST+NW*4096;
constexpr float OSCALE=16.0f;
constexpr float C2=0.125f*1.4426950408889634f;
__device__ __forceinline__ void glds16(const void*gsrc,unsigned lds_dst){unsigned keep;
  asm volatile("s_mov_b32 %0, m0\n\ts_mov_b32 m0, %2\n\ts_nop 0\n\tglobal_load_lds_dwordx4 %1, off\n\ts_mov_b32 m0, %0":"=&s"(keep):"v"(gsrc),"s"(lds_dst):"memory");}
__device__ __forceinline__ float max3f(float a,float b,float c){float r;asm("v_max3_f32 %0, %1, %2, %3":"=v"(r):"v"(a),"v"(b),"v"(c));return r;}
__device__ __forceinline__ float max2f(float a,float b){float r;asm("v_max_f32_e32 %0, %1, %2":"=v"(r):"v"(a),"v"(b));return r;}
__device__ __forceinline__ float fadd_s(float a,float b){float r;asm("v_add_f32_e32 %0, %1, %2":"=v"(r):"v"(a),"v"(b));return r;}
__device__ __forceinline__ float fsub_s(float a,float b){float r;asm("v_sub_f32_e32 %0, %1, %2":"=v"(r):"v"(a),"v"(b));return r;}
typedef float f32x2_t __attribute__((ext_vector_type(2))); typedef __bf16 bf16x2_t __attribute__((ext_vector_type(2)));
__device__ __forceinline__ unsigned cvtpk_s(float lo,float hi){f32x2_t v={lo,hi};bf16x2_t b=__builtin_convertvector(v,bf16x2_t);return __builtin_bit_cast(unsigned,b);}
#define WAIT_BAR(N) asm volatile("s_waitcnt vmcnt(" #N ") lgkmcnt(0)\n\ts_barrier":::"memory")
#define WAIT_BAR2(NK,NV) do{ if(wid<4) WAIT_BAR(NK); else WAIT_BAR(NV); }while(0)

typedef int v8i_t __attribute__((ext_vector_type(8)));
#define MFMA8(a,b,c) __builtin_amdgcn_mfma_scale_f32_32x32x64_f8f6f4((a),(b),(c),0,0,0,0,0,0)
#define MFMA8P(a,b,c) __builtin_amdgcn_mfma_scale_f32_32x32x64_f8f6f4((a),(b),(c),1,0,0,0,0,0)
typedef __attribute__((address_space(3))) const char* lds_cptr;
typedef short v4i16_t __attribute__((ext_vector_type(4)));
__device__ __forceinline__ v8i_t kfrag(lds_cptr kp,int ka0,int ka1){
  const u32x4 lo=*(const __attribute__((address_space(3))) u32x4*)(kp+ka0), hi_=*(const __attribute__((address_space(3))) u32x4*)(kp+ka1);
  return (v8i_t){(int)lo.x,(int)lo.y,(int)lo.z,(int)lo.w,(int)hi_.x,(int)hi_.y,(int)hi_.z,(int)hi_.w}; }
__device__ __forceinline__ float rowmax(const f32x16&p0,const f32x16&p1){
  float a=max3f(p0[0],p0[1],p1[0]),b=max3f(p0[2],p0[3],p1[1]);a=max3f(a,p1[2],p1[3]);
  #pragma unroll
  for(int r=4;r<16;r+=4){a=max3f(a,p0[r],p0[r+1]);b=max3f(b,p0[r+2],p0[r+3]);a=max3f(a,p1[r],p1[r+1]);b=max3f(b,p1[r+2],p1[r+3]);}
  const float m=max2f(a,b);
  auto rr=__builtin_amdgcn_permlane32_swap(__float_as_uint(m),__float_as_uint(m),false,false);
  return max2f(__uint_as_float(rr[0]),__uint_as_float(rr[1]));
}
#ifndef ATTN_STORE16
#define ATTN_STORE16(p,v) (*(u32x4*)(p)=(v))
#endif
template<int THRL> __device__ __forceinline__ void attn_unit(int b,int h,int qb,const bf16*Q,const unsigned char*__restrict__ K8,const unsigned char*__restrict__ V8T,unsigned char*O,const float*__restrict__ qgain,const bool SM,char*shm){
  int tid_=threadIdx.x; asm volatile("":"+v"(tid_));
  const int tid=tid_,lane=tid&63,r32=lane&31,hi=lane>>5; const int wid=__builtin_amdgcn_readfirstlane(tid>>6);
  const long rowbase=(long)b*SEQ; const int q0=qb*QB;
  const bf16*Qw=Q+(rowbase+q0+wid*QBLK)*QP+h*D;
  const unsigned lds0=(unsigned)(uintptr_t)shm;
  float*wsf=(float*)(shm+LDS_WS)+wid*64;
  const unsigned char*ksrc=K8+(rowbase+16*(wid&3)+(lane>>2))*128+(h>>2)*64+(((lane&3)^((lane>>4)&3))*16);
  const unsigned char*vsrc=V8T+((long)(b*2+(h>>2))*(SEQ/KVBLK))*4096+(16*(wid&3)+(lane>>2))*64+(((lane&3)^((lane>>4)&3))*16);
  const unsigned kdst=lds0+LDS_K+(wid&3)*1024, vdst=lds0+LDS_V+(wid&3)*1024;
  #define DMA_K(t,slot) do{ if(wid<4) glds16(ksrc+(long)(t)*KVBLK*128,(unsigned)__builtin_amdgcn_readfirstlane(kdst+(slot))); }while(0)
  #define DMA_V(t,slot) do{ if(wid>=4) glds16(vsrc+(long)(t)*4096,(unsigned)__builtin_amdgcn_readfirstlane(vdst+(slot))); }while(0)
  v8i_t kfA,kfB;
  const int ksw=(r32>>2)&3, ka0=r32*64+(((2*hi)^ksw)*16), ka1=r32*64+(((2*hi+1)^ksw)*16);
  const lds_cptr shm3=(lds_cptr)shm; const lds_cptr kp0=shm3+LDS_K; const lds_cptr vp0=shm3+LDS_V;
  constexpr int NT=SEQ/KVBLK;
  DMA_K(0,0);DMA_V(0,0);DMA_K(1,KSLOTB);
  v8i_t q8;
  {
    u32x4 qraw[4];
    #pragma unroll
    for(int c=0;c<4;++c)qraw[c]=*reinterpret_cast<const u32x4*>(&Qw[(long)r32*QP+hi*32+c*8]);
    float f[32]; float ss=0.f;
    #pragma unroll
    for(int c=0;c<4;++c){
      #pragma unroll
      for(int j=0;j<4;++j){ const unsigned w=qraw[c][j]; f[c*8+2*j]=__builtin_bit_cast(float,w<<16); f[c*8+2*j+1]=__builtin_bit_cast(float,w&0xffff0000u); ss+=f[c*8+2*j]*f[c*8+2*j]+f[c*8+2*j+1]*f[c*8+2*j+1]; } }
    { auto rr=__builtin_amdgcn_permlane32_swap(__float_as_uint(ss),__float_as_uint(ss),false,false); ss=__uint_as_float(rr[0])+__uint_as_float(rr[1]); }
    const float rsq=C2/sqrtf(ss*(1.0f/64.0f)+1e-6f);
    const int pos=q0+wid*QBLK+r32; const float paxis=hi?(float)(pos&63):(float)(pos>>6);
    #pragma unroll
    for(int pp=0;pp<8;++pp){
      float r_[4];
      #pragma unroll
      for(int e=0;e<2;++e){ const int p=2*pp+e;
        float rev=paxis*__builtin_amdgcn_exp2f(-(float)p*(13.287712379549449f/16.0f))*0.15915494309189535f; rev-=floorf(rev);
        const float sn=__builtin_amdgcn_sinf(rev), cs=__builtin_amdgcn_cosf(rev);
        const float a0=f[2*p]*rsq*qgain[hi*32+2*p], a1=f[2*p+1]*rsq*qgain[hi*32+2*p+1];
        r_[2*e]=a0*cs-a1*sn; r_[2*e+1]=a0*sn+a1*cs; }
      int w_=0; w_=__builtin_amdgcn_cvt_pk_fp8_f32(r_[0],r_[1],w_,false); w_=__builtin_amdgcn_cvt_pk_fp8_f32(r_[2],r_[3],w_,true); q8[pp]=w_;
    }
  }
  float mhat=0.f;f32x16 o[2];o[0]=f32x16{};o[1]=f32x16{};const f32x16 z16=f32x16{};
  f32x16 lt=f32x16{}; v8i_t ones8; { _Pragma("unroll") for(int i_=0;i_<8;++i_)ones8[i_]=0x38383838; } asm volatile("":"+v"(ones8));
  const int qrel=wid*QBLK+r32;
  #define CMASK(P0,P1,t) do{}while(0)
  bool resc=false;
  #define START(P0,P1) do{ resc=false; \
    if(!SM){ const float rm=rowmax(P0,P1); const float dl=rm-7.0f; mhat=fadd_s(mhat,dl); \
      _Pragma("unroll") for(int r=0;r<16;++r){P0[r]=fsub_s(P0[r],dl);P1[r]=fsub_s(P1[r],dl);} } \
    _Pragma("unroll") for(int r=0;r<16;++r)P0[r]=__builtin_amdgcn_exp2f(P0[r]); }while(0)
  #define RESC() do{ if(resc){ asm volatile("s_waitcnt lgkmcnt(0)":::"memory"); \
      _Pragma("unroll") for(int r=0;r<16;++r){ const float f_=wsf[crow(r,hi)]; o[0][r]*=f_; o[1][r]*=f_; lt[r]*=f_; } } }while(0)
  f32x16 pA0,pA1,pB0,pB1;
  int sl_cur=0,sl_next=KSLOTB;
  int vs_prev=0,vs_cur=0,vs_next=SLOTB,vs_nn=2*SLOTB;
  #define ROT() do{sl_cur=sl_next;sl_next=(sl_next==(NSLOT-1)*KSLOTB)?0:sl_next+KSLOTB; vs_prev=vs_cur;vs_cur=vs_next;vs_next=vs_nn;vs_nn=(vs_nn==(NVSLOT-1)*SLOTB)?0:vs_nn+SLOTB;}while(0)
  DMA_K(2,2*KSLOTB);DMA_V(1,SLOTB);
  WAIT_BAR(2);
  kfA=kfrag(kp0,ka0,ka1);kfB=kfrag(kp0+2048,ka0,ka1);
  pA0=MFMA8(kfA,q8,z16);pA1=MFMA8(kfB,q8,z16);asm volatile("s_nop 15\n\ts_nop 7":"+v"(pA0),"+v"(pA1));CMASK(pA0,pA1,0);
  START(pA0,pA1);
  _Pragma("unroll") for(int r=0;r<16;++r)pA1[r]=__builtin_amdgcn_exp2f(pA1[r]);
  WAIT_BAR(0);
  DMA_K(3,0);DMA_V(2,2*SLOTB);
  ROT();
  kfA=kfrag(kp0+sl_cur,ka0,ka1);kfB=kfrag(kp0+sl_cur+2048,ka0,ka1);
  WAIT_BAR(1);
  v8i_t vfA,vfB,p8; p8=v8i_t{};
  #define PIN(x) asm volatile("":"+v"(x))
  #define MX3(a,b,c) __builtin_fmaxf(__builtin_fmaxf((a),(b)),(c))
  #define GAPA(MF,W0,W1,W2,W3,PW) do{ MF; W0; W1; W2; W3; PIN(PW); SBAR(); }while(0)
  #define EX(v) __builtin_amdgcn_exp2f(v)
  #define GAPB(MF,X,B) do{ MF; X[B]=EX(X[B]); X[B+1]=EX(X[B+1]); X[B+2]=EX(X[B+2]); X[B+3]=EX(X[B+3]); PIN(X); SBAR(); }while(0)
  #define PK8(k,P,B) do{ p8[k]=__builtin_amdgcn_cvt_pk_bf8_f32(P[B],P[B+1],p8[k],false); }while(0)
  #define PK8H(k,P,B) do{ p8[k]=__builtin_amdgcn_cvt_pk_bf8_f32(P[B],P[B+1],p8[k],true); }while(0)
  #define KRD(G,j) do{ if(G){ if((j)==0) kfA=kfrag(kp0+sl_next,ka0,ka1); else kfB=kfrag(kp0+sl_next+2048,ka0,ka1); SBAR(); } }while(0)
  #define STEP(C0,C1,P0,P1,t,GK,GV,GL) do{ SBAR(); \
    const lds_cptr vp_=vp0+vs_prev; \
    vfA=kfrag(vp_,ka0,ka1); SBAR(); \
    GAPA(C0=MFMA8(kfA,q8,z16), PK8(0,P0,0), PK8H(0,P0,2), PK8(1,P0,4), PK8H(1,P0,6), p8); \
    vfB=kfrag(vp_+2048,ka0,ka1); SBAR(); \
    GAPA(C1=MFMA8(kfB,q8,z16), PK8(2,P0,8), PK8H(2,P0,10), PK8(3,P0,12),PK8H(3,P0,14), p8); \
    GAPA((void)0, PK8(4,P1,0), PK8H(4,P1,2), PK8(5,P1,4), PK8H(5,P1,6), p8); \
    GAPA((void)0, PK8(6,P1,8), PK8H(6,P1,10), PK8(7,P1,12),PK8H(7,P1,14), p8); \
    if(GK){DMA_K((t)+3,sl_cur);} if(GV){DMA_V((t)+2,vs_nn);} \
    CMASK(C0,C1,t); \
    if(!SM){ _Pragma("unroll") for(int r=0;r<16;++r){C0[r]-=mhat;C1[r]-=mhat;} \
      float a=MX3(C0[0],C0[1],C1[0]),b=MX3(C0[2],C0[3],C1[1]); a=MX3(a,C1[2],C1[3]); \
      _Pragma("unroll") for(int r=4;r<16;r+=4){a=MX3(a,C0[r],C0[r+1]);b=MX3(b,C0[r+2],C0[r+3]);a=MX3(a,C1[r],C1[r+1]);b=MX3(b,C1[r+2],C1[r+3]);} \
      float rm=__builtin_fmaxf(a,b); { auto rr=__builtin_amdgcn_permlane32_swap(__float_as_uint(rm),__float_as_uint(rm),false,false); rm=__builtin_fmaxf(__uint_as_float(rr[0]),__uint_as_float(rr[1])); } \
      resc=false; \
      if(__builtin_expect(__any(rm>(float)THRL),0)){ const float dl=__builtin_fmaxf(rm,0.f); mhat+=dl; \
        _Pragma("unroll") for(int r=0;r<16;++r){C0[r]-=dl;C1[r]-=dl;} \
        const float f=__builtin_amdgcn_exp2f(-dl); if(hi==0)wsf[r32]=f; resc=true; } } \
    SBAR(); \
    GAPB(o[0]=MFMA8P(p8,vfA,o[0]), C0,0); \
    GAPB(o[1]=MFMA8P(p8,vfB,o[1]), C0,4); \
    KRD(GL,0); GAPB(lt=MFMA8P(p8,ones8,lt), C0,8); \
    GAPB((void)0, C0,12); \
    KRD(GL,1); GAPB((void)0, C1,0); \
    GAPB((void)0, C1,4); \
    GAPB((void)0, C1,8); \
    GAPB((void)0, C1,12); \
    }while(0)
  int t=1;
  #undef CMASK
  #define CMASK(P0,P1,t) do{}while(0)
  for(;t+5<NT;t+=2){
    STEP(pB0,pB1,pA0,pA1,t,true,true,true);     WAIT_BAR2(1,2); RESC(); ROT();
    STEP(pA0,pA1,pB0,pB1,t+1,true,true,true);   WAIT_BAR2(1,2); RESC(); ROT();
  }
  #undef CMASK
  #define CMASK(P0,P1,t) do{}while(0)
  #define ENDW(tt) do{ if((tt)+3<NT){WAIT_BAR2(1,2);} else if((tt)+3==NT){WAIT_BAR2(0,2);} else {WAIT_BAR(0);} }while(0)
  for(;t+1<NT;t+=2){
    STEP(pB0,pB1,pA0,pA1,t,(t+3<NT),(t+2<NT),(t+1<NT));       ENDW(t);   RESC(); ROT();
    STEP(pA0,pA1,pB0,pB1,t+1,(t+4<NT),(t+3<NT),(t+2<NT));     ENDW(t+1); RESC(); ROT();
  }
  STEP(pB0,pB1,pA0,pA1,NT-1,false,false,false); RESC();
  {
    PK8(0,pB0,0);PK8H(0,pB0,2);PK8(1,pB0,4);PK8H(1,pB0,6);PK8(2,pB0,8);PK8H(2,pB0,10);PK8(3,pB0,12);PK8H(3,pB0,14);PK8(4,pB1,0);PK8H(4,pB1,2);PK8(5,pB1,4);PK8H(5,pB1,6);PK8(6,pB1,8);PK8H(6,pB1,10);PK8(7,pB1,12);PK8H(7,pB1,14);
    SBAR(); vfA=kfrag(vp0+vs_cur,ka0,ka1); vfB=kfrag(vp0+vs_cur+2048,ka0,ka1); o[0]=MFMA8P(p8,vfA,o[0]); o[1]=MFMA8P(p8,vfB,o[1]); lt=MFMA8P(p8,ones8,lt); }
  #undef PK8
  #undef PK8H
  #undef PIN
  #undef MX3
  #undef GAPA
  #undef GAPB
  #undef EX
  #undef KRD
  #undef STEP
  #undef ENDW
  float rli[16];
  #pragma unroll
  for(int r=0;r<16;++r)rli[r]=__builtin_amdgcn_rcpf(lt[r]);
  unsigned char*Ow=O+(rowbase+q0+wid*QBLK)*OP+h*D;
  { unsigned char*stg=(unsigned char*)(shm+LDS_OST)+wid*2048;
    #pragma unroll
    for(int r=0;r<16;++r){const int orow=crow(r,hi);
      #pragma unroll
      for(int d0=0;d0<2;++d0){ int w8=0; w8=__builtin_amdgcn_cvt_pk_fp8_f32(fminf(fmaxf(o[d0][r]*rli[r]*OSCALE,-448.f),448.f),0.f,w8,false); stg[orow*64+d0*32+r32]=(unsigned char)(w8&0xff); } }
    asm volatile("s_waitcnt lgkmcnt(0)":::"memory");
    #pragma unroll
    for(int i=0;i<2;++i){const int row=i*16+(lane>>2),ch=lane&3; const u32x4 v=*(const u32x4*)(stg+row*64+ch*16); ATTN_STORE16(Ow+(long)row*OP+ch*16,v);} }
  asm volatile("s_waitcnt lgkmcnt(0)\n\ts_barrier":::"memory");
  #undef DMA_K
  #undef DMA_V
  #undef CMASK
  #undef START
  #undef RESC
  #undef ROT
}
constexpr int ATTN_LDS_BYTES=LDS_BYTES;
struct AttnTensors { const bf16* Q; const unsigned char* K8; const unsigned char* V8T; unsigned char* O; const float* qgain; const float* kgain; };
struct AttnUnit { int bh; int qb; };
struct StaticOrder {
  int vcu,G;
  __device__ __forceinline__ explicit StaticOrder(int grid,int block):vcu((grid%8==0)?(block%8)*(grid/8)+block/8:block),G(grid){}
  __device__ __forceinline__ bool next(int i,AttnUnit&u)const{ const int id=vcu+i*G; if(id>=BATCH*NHEAD*NQB)return false; const int grp=(id&255)>>5; u.bh=(grp>>1)*NHEAD+(grp&1)*4+(id>>8); u.qb=id&31; return true; }
  __device__ __forceinline__ void a_ready(const AttnUnit&)const{}
  __device__ __forceinline__ void done(const AttnUnit&)const{}
};
template<class Sched,int THRL=15> __device__ __forceinline__ void attn_phase(char*lds,const AttnTensors&T,const Sched&S){
  AttnUnit u;
  const int ln=threadIdx.x&63; float gq=fabsf(T.qgain[ln]),gk=fabsf(T.kgain[ln]);
  #pragma unroll
  for(int o_=32;o_>=1;o_>>=1){gq=fmaxf(gq,__shfl_xor(gq,o_));gk=fmaxf(gk,__shfl_xor(gk,o_));}
  const float bnd=64.0f*C2*1.02f*gq*gk;
#ifdef ATTN_FORCE_ONLINE
  const bool sm=false;
#else
  const bool sm=__builtin_amdgcn_readfirstlane(bnd<=15.5f?1:0)!=0;
#endif
  for(int i=0;S.next(i,u);++i){ S.a_ready(u); attn_unit<THRL>(u.bh/NHEAD,u.bh%NHEAD,u.qb,T.Q,T.K8,T.V8T,T.O,T.qgain,sm,lds); S.done(u); }
}
#undef SBAR
#undef WAIT_BAR
}

constexpr int NWAVES = 8, NTHR = NWAVES * 64;
constexpr int BATCH = 4, SEQ = 8192, DM = 1024, T = BATCH * SEQ;
constexpr int INW = 2832, INW_MAIN = 2816;
constexpr float NORM_EPS = 1e-6f;
constexpr int MLH = 4, MLD = 128, NCHUNK = 64, CHL = 128;
constexpr int PEER_E = 16384;
constexpr size_t MiB = 1u << 20;
constexpr size_t WS_CTL = 0, CTL_ZERO_BYTES = 1 * MiB;
constexpr size_t WS_WIN = 2 * MiB, WS_WOUT = 8 * MiB, WS_WEFF = 10 * MiB;
constexpr size_t WS_SSQ = 14 * MiB, WS_LOGI = 16 * MiB, WS_LOGF = 17 * MiB, WS_SCAL = 18 * MiB, WS_MPREV = 18 * MiB + 65536, WS_DN = 19 * MiB;
constexpr size_t WS_DOWN8 = 32 * MiB, WS_UP8 = 48 * MiB, WS_SD = 20 * MiB, WS_SU = 20 * MiB + 65536, WS_XB = 96 * MiB, WS_MIX = 336 * MiB;
constexpr size_t WS_C8 = 21 * MiB, WS_CSC = 25 * MiB, WS_RR = 25 * MiB + 262144, WS_XS = 26 * MiB, WS_XQ = 128 * MiB;
constexpr size_t WS_PART = 96 * MiB;
constexpr size_t WS_AQ = 160 * MiB, WS_AK = 192 * MiB, WS_AV = 200 * MiB, WS_MQ = 208 * MiB, WS_MK = 240 * MiB, WS_MV = 272 * MiB, WS_MO = 304 * MiB;
constexpr size_t WS_CST = 400 * MiB;
constexpr size_t WS_XA8 = 368 * MiB, WS_SA = 25 * MiB + 524288;
constexpr float W8SCALE = 32.0f, MIX8SCALE = 16.0f;
constexpr size_t WS_AV8T = 26 * MiB;
constexpr size_t WS_AK8 = 21 * MiB;
constexpr size_t WS_HB = 160 * MiB, WS_SC = 224 * MiB, WS_IDS = 400 * MiB, WS_GATES = 416 * MiB, WS_END = 464 * MiB;

constexpr int CW_BAR = 4096, CW_WMAX = 16, CW_WCNT = 80;
constexpr int LDS_BYTES = 147456, LDSCTL_OFF = LDS_BYTES - 256;
constexpr int TPITCH = 136;
constexpr int TILE_B = 128 * TPITCH * 2;

#define GAS __attribute__((address_space(1)))
#define LAS __attribute__((address_space(3)))
typedef unsigned short bf16;
typedef unsigned v4u __attribute__((ext_vector_type(4)));
typedef unsigned v2u __attribute__((ext_vector_type(2)));
typedef float f32x4 __attribute__((ext_vector_type(4)));
typedef float f32x2 __attribute__((ext_vector_type(2)));
typedef short bf16x8 __attribute__((ext_vector_type(8)));
typedef __bf16 bf16x2v __attribute__((ext_vector_type(2)));
#define FRESH_TID() int tid = threadIdx.x; asm volatile("" : "+v"(tid)); const int lane = tid & 63; const int wave = __builtin_amdgcn_readfirstlane(tid >> 6); (void)lane; (void)wave
#define LDS_WAIT() asm volatile("s_waitcnt lgkmcnt(0)" ::: "memory")
#define VM_WAIT() asm volatile("s_waitcnt vmcnt(0)" ::: "memory")
typedef __bf16 bf16x2cv __attribute__((ext_vector_type(2)));
__device__ __forceinline__ unsigned pk2(float lo, float hi) { f32x2 v = {lo, hi}; return __builtin_bit_cast(unsigned, __builtin_convertvector(v, bf16x2cv)); }
__device__ __forceinline__ unsigned f2bf(float f) { return pk2(f, 0.f) & 0xffffu; }
__device__ __forceinline__ float bf2f(unsigned short b) { return __builtin_bit_cast(float, (unsigned)b << 16); }
__device__ __forceinline__ float bflo(unsigned u) { return __builtin_bit_cast(float, u << 16); }
__device__ __forceinline__ float bfhi(unsigned u) { return __builtin_bit_cast(float, u & 0xffff0000u); }
__device__ __forceinline__ float fexp(float x) { return __builtin_amdgcn_exp2f(x * 1.4426950408889634f); }
__device__ __forceinline__ float fsigmoid(float x) { return __builtin_amdgcn_rcpf(1.0f + fexp(-x)); }
__device__ __forceinline__ float dot2bf(unsigned a, unsigned b, float acc) { return __builtin_amdgcn_fdot2_f32_bf16(__builtin_bit_cast(bf16x2v, a), __builtin_bit_cast(bf16x2v, b), acc, false); }
__device__ __forceinline__ float wave_sum(float v) {
#pragma unroll
    for (int o = 1; o < 64; o <<= 1) v += __shfl_xor(v, o);
    return v;
}
__device__ __forceinline__ float wave_max(float v) {
#pragma unroll
    for (int o = 1; o < 64; o <<= 1) v = fmaxf(v, __shfl_xor(v, o));
    return v;
}
__device__ __forceinline__ float wave_incl_add(float v, int lane) {
#pragma unroll
    for (int o = 1; o < 64; o <<= 1) { const float t = __shfl_up(v, o); if (lane >= o) v += t; }
    return v;
}
__device__ __forceinline__ float wave_incl_max(float v, int lane) {
#pragma unroll
    for (int o = 1; o < 64; o <<= 1) { const float t = __shfl_up(v, o); if (lane >= o) v = fmaxf(v, t); }
    return v;
}
__device__ __forceinline__ float wave_incl_max_rev(float v, int lane) {
#pragma unroll
    for (int o = 1; o < 64; o <<= 1) { const float t = __shfl_down(v, o); if (lane + o < 64) v = fmaxf(v, t); }
    return v;
}
__device__ __forceinline__ float reduce16(const float (&p)[16], int lane) {
    float q[8], r[4], s[2];
    { const bool b = lane & 1;
#pragma unroll
      for (int i = 0; i < 8; ++i) { const float send = b ? p[i] : p[i + 8], keep = b ? p[i + 8] : p[i]; q[i] = keep + __shfl_xor(send, 1); } }
    { const bool b = lane & 2;
#pragma unroll
      for (int i = 0; i < 4; ++i) { const float send = b ? q[i] : q[i + 4], keep = b ? q[i + 4] : q[i]; r[i] = keep + __shfl_xor(send, 2); } }
    { const bool b = lane & 4;
#pragma unroll
      for (int i = 0; i < 2; ++i) { const float send = b ? r[i] : r[i + 2], keep = b ? r[i + 2] : r[i]; s[i] = keep + __shfl_xor(send, 4); } }
    float v;
    { const bool b = lane & 8; const float send = b ? s[0] : s[1], keep = b ? s[1] : s[0]; v = keep + __shfl_xor(send, 8); }
    v += __shfl_xor(v, 16); v += __shfl_xor(v, 32);
    return v;
}
__device__ __forceinline__ int bitrev4(int x) { return ((x & 1) << 3) | ((x & 2) << 1) | ((x & 4) >> 1) | ((x & 8) >> 3); }

template <int KD> __device__ __forceinline__ void wave_gemm(const LAS bf16* A, int arow0, const LAS bf16* Bt, f32x4 (&acc)[8], int lane) {
    const int fr = lane & 15, fq = lane >> 4;
#pragma unroll
    for (int ks = 0; ks < KD / 32; ++ks) {
        const bf16x8 a = *(const LAS bf16x8*)(A + (arow0 + fr) * TPITCH + ks * 32 + fq * 8);
#pragma unroll
        for (int nt = 0; nt < 8; ++nt) {
            const bf16x8 b = *(const LAS bf16x8*)(Bt + (nt * 16 + fr) * TPITCH + ks * 32 + fq * 8);
            acc[nt] = __builtin_amdgcn_mfma_f32_16x16x32_bf16(a, b, acc[nt], 0, 0, 0);
        }
    }
}

struct Ptrs {
    const float *x, *norm1_gain, *w_in, *att_q_gain, *att_k_gain, *ml_conv_w, *ml_conv_b, *ml_igate_bias, *ml_fgate_bias, *ml_out_gain, *w_out, *norm2_gain, *peer_w_query, *peer_sub_keys, *peer_down, *peer_up;
    float* out; unsigned char* ws;
};

__device__ __forceinline__ unsigned pk4_fp8(float a, float b, float c, float d) { int w = 0; w = __builtin_amdgcn_cvt_pk_fp8_f32(fminf(fmaxf(a, -448.f), 448.f), fminf(fmaxf(b, -448.f), 448.f), w, false);
    w = __builtin_amdgcn_cvt_pk_fp8_f32(fminf(fmaxf(c, -448.f), 448.f), fminf(fmaxf(d, -448.f), 448.f), w, true); return (unsigned)w; }
__device__ __forceinline__ unsigned pk4_i8(float a, float b, float c, float d) {
    const int ia = (int)fminf(fmaxf(rintf(a), -127.f), 127.f), ib = (int)fminf(fmaxf(rintf(b), -127.f), 127.f), ic = (int)fminf(fmaxf(rintf(c), -127.f), 127.f), id = (int)fminf(fmaxf(rintf(d), -127.f), 127.f);
    return (unsigned)(ia & 0xff) | ((unsigned)(ib & 0xff) << 8) | ((unsigned)(ic & 0xff) << 16) | ((unsigned)id << 24); }
template <int MODE> __device__ __forceinline__ void p0_transpose_item(const float* W, int ldw, const float* gain, unsigned char* WT, int K, LAS float* scr, int kb, int nb, int lane, float qs = 1.0f) {
    constexpr bool F8 = MODE == 1;
    const int k0 = 64 * kb, n0 = 32 * nb;
#pragma unroll 8
    for (int i = 0; i < 32; ++i) { const int kk = 2 * i + (lane >> 5); const float g = (gain ? gain[k0 + kk] : 1.0f) * (F8 ? W8SCALE : (MODE == 2 ? qs : 1.0f)); scr[kk * 33 + (lane & 31)] = W[(size_t)(k0 + kk) * ldw + n0 + (lane & 31)] * g; }
    LDS_WAIT(); asm volatile("" ::: "memory");
    const int c = lane & 7;
#pragma unroll
    for (int j = 0; j < 4; ++j) { const int n = (lane >> 3) + 8 * j; const LAS float* s = scr + (8 * c) * 33 + n;
        if constexpr (F8) { v2u o; o.x = pk4_fp8(s[0 * 33], s[1 * 33], s[2 * 33], s[3 * 33]); o.y = pk4_fp8(s[4 * 33], s[5 * 33], s[6 * 33], s[7 * 33]);
            *(GAS v2u*)(WT + (size_t)(n0 + n) * K + k0 + 8 * c) = o; }
        else if constexpr (MODE == 2) { v2u o; o.x = pk4_i8(s[0 * 33], s[1 * 33], s[2 * 33], s[3 * 33]); o.y = pk4_i8(s[4 * 33], s[5 * 33], s[6 * 33], s[7 * 33]);
            *(GAS v2u*)(WT + (size_t)(n0 + n) * K + k0 + 8 * c) = o; }
        else { v4u o; o.x = pk2(s[0 * 33], s[1 * 33]); o.y = pk2(s[2 * 33], s[3 * 33]); o.z = pk2(s[4 * 33], s[5 * 33]); o.w = pk2(s[6 * 33], s[7 * 33]);
            *(GAS v4u*)((bf16*)WT + (size_t)(n0 + n) * K + k0 + 8 * c) = o; } }
    LDS_WAIT(); asm volatile("" ::: "memory");
}

__device__ __forceinline__ void p0_wmax(const Ptrs& P, int vcu, int G) {
    FRESH_TID();
    float mx = 0.f;
    constexpr int NV = DM * (INW_MAIN / 4);
    for (int base = vcu * NTHR + tid; base < NV; base += 8 * G * NTHR) {
        f32x4 v[8]; float g[8];
#pragma unroll
        for (int u = 0; u < 8; ++u) { const int idx = base + u * G * NTHR, ic = idx < NV ? idx : base; const int k = ic / (INW_MAIN / 4), c4 = ic % (INW_MAIN / 4);
            v[u] = *(const f32x4*)(P.w_in + (size_t)k * INW + c4 * 4); g[u] = fabsf(P.norm1_gain[k]); }
#pragma unroll
        for (int u = 0; u < 8; ++u) mx = fmaxf(mx, g[u] * fmaxf(fmaxf(fabsf(v[u][0]), fabsf(v[u][1])), fmaxf(fabsf(v[u][2]), fabsf(v[u][3]))));
    }
    mx = wave_max(mx);
    if (lane == 0) atomicMax((unsigned*)(P.ws + WS_CTL) + CW_WMAX, __builtin_bit_cast(unsigned, mx));
}
__device__ __forceinline__ void p0_weights(const Ptrs& P, LAS unsigned char* lds, int vcu, int G) {
    FRESH_TID();
    const int gw = vcu * NWAVES + wave, NGW = G * NWAVES;
    unsigned char* ws = P.ws;
    {
        const float wmax_in = __builtin_bit_cast(float, __hip_atomic_load((unsigned*)(ws + WS_CTL) + CW_WMAX, __ATOMIC_RELAXED, __HIP_MEMORY_SCOPE_AGENT)); const float qs_in = wmax_in > 0.f ? 127.0f / wmax_in : 0.f;
        LAS float* scr = (LAS float*)(lds + wave * 8704);
        constexpr int I_IN = 16 * 88, I_OUT = 16 * 32;
        for (int it = gw; it < I_IN + I_OUT; it += NGW) {
            if (it < I_IN) p0_transpose_item<2>(P.w_in, INW, P.norm1_gain, ws + WS_WIN, DM, scr, it / 88, it % 88, lane, qs_in);
            else { const int r = it - I_IN; p0_transpose_item<1>(P.w_out, DM, nullptr, ws + WS_WOUT, DM, scr, r / 32, r % 32, lane); }
        }
    }
    __syncthreads();
    for (int item = vcu; item < 256; item += G) {
        const int g = item >> 4, k0 = (item & 15) * 64;
        LAS bf16* SKB = (LAS bf16*)lds; LAS bf16* WQB = (LAS bf16*)(lds + TILE_B);
#pragma unroll
        for (int i = 0; i < 4; ++i) { const int idx = tid + NTHR * i, r = idx >> 5, c4 = idx & 31;
            const f32x4 v = *(const f32x4*)(P.peer_w_query + (size_t)(k0 + r) * 2048 + g * 128 + c4 * 4) * P.norm2_gain[k0 + r];
            v2u w; w.x = pk2(v[0], v[1]); w.y = pk2(v[2], v[3]); *(LAS v2u*)(WQB + r * TPITCH + c4 * 4) = w; }
#pragma unroll
        for (int i = 0; i < 8; ++i) { const int idx = tid + NTHR * i, r = idx >> 5, c4 = idx & 31;
            const f32x4 v = *(const f32x4*)(P.peer_sub_keys + ((size_t)g * 128 + r) * 128 + c4 * 4);
            v2u w; w.x = pk2(v[0], v[1]); w.y = pk2(v[2], v[3]); *(LAS v2u*)(SKB + r * TPITCH + c4 * 4) = w; }
        __syncthreads();
        {
            const int fr = lane & 15, fq = lane >> 4;
            f32x4 acc[4];
#pragma unroll
            for (int nt = 0; nt < 4; ++nt) acc[nt] = (f32x4){0.f, 0.f, 0.f, 0.f};
#pragma unroll
            for (int ks = 0; ks < 4; ++ks) {
                const bf16x8 a = *(const LAS bf16x8*)(SKB + (wave * 16 + fr) * TPITCH + ks * 32 + fq * 8);
#pragma unroll
                for (int nt = 0; nt < 4; ++nt) { const bf16x8 b = *(const LAS bf16x8*)(WQB + (nt * 16 + fr) * TPITCH + ks * 32 + fq * 8); acc[nt] = __builtin_amdgcn_mfma_f32_16x16x32_bf16(a, b, acc[nt], 0, 0, 0); }
            }
            bf16* WE = (bf16*)(ws + WS_WEFF);
#pragma unroll
            for (int nt = 0; nt < 4; ++nt)
#pragma unroll
                for (int r = 0; r < 4; ++r) WE[(size_t)(g * 128 + wave * 16 + fq * 4 + r) * DM + k0 + nt * 16 + fr] = (bf16)f2bf(acc[nt][r]);
        }
        __syncthreads();
    }
}
__device__ __forceinline__ void p0_stream(const Ptrs& P, LAS unsigned char* lds, int vcu, int G) {
    FRESH_TID();
    const int gw = vcu * NWAVES + wave, NGW = G * NWAVES;
    unsigned char* ws = P.ws;
    {
    f32x4 nxt[4];
    { const int rc = gw < 2 * PEER_E ? gw : 0; const bool up = rc >= PEER_E; const int e = up ? rc - PEER_E : rc;
      const f32x4* src = (const f32x4*)((up ? P.peer_up : P.peer_down) + (size_t)e * DM) + lane; nxt[0] = src[0]; nxt[1] = src[64]; nxt[2] = src[128]; nxt[3] = src[192]; }
    for (int r = gw; r < 2 * PEER_E; r += NGW) {
        const bool up = r >= PEER_E; const int e = up ? r - PEER_E : r;
        f32x4 v[4] = {nxt[0], nxt[1], nxt[2], nxt[3]};
        { const int rn = r + NGW, rc = rn < 2 * PEER_E ? rn : r; const bool upn = rc >= PEER_E; const int en = upn ? rc - PEER_E : rc;
          const f32x4* src = (const f32x4*)((upn ? P.peer_up : P.peer_down) + (size_t)en * DM) + lane;
          nxt[0] = __builtin_nontemporal_load(src); nxt[1] = __builtin_nontemporal_load(src + 64); nxt[2] = __builtin_nontemporal_load(src + 128); nxt[3] = __builtin_nontemporal_load(src + 192); }
        if (!up) { const f32x4* gp = (const f32x4*)P.norm2_gain + lane; v[0] = v[0] * gp[0]; v[1] = v[1] * gp[64]; v[2] = v[2] * gp[128]; v[3] = v[3] * gp[192]; }
        float mx = 0.f;
#pragma unroll
        for (int q = 0; q < 4; ++q) mx = fmaxf(mx, fmaxf(fmaxf(fabsf(v[q][0]), fabsf(v[q][1])), fmaxf(fabsf(v[q][2]), fabsf(v[q][3]))));
        mx = wave_max(mx);
        {
            float ss = 0.f;
#pragma unroll
            for (int q = 0; q < 4; ++q) ss += (v[q][0] * v[q][0] + v[q][1] * v[q][1]) + (v[q][2] * v[q][2] + v[q][3] * v[q][3]);
            const float clip = fminf(mx, 2.5f * sqrtf(wave_sum(ss) * (1.0f / DM)));
            const float inv4 = clip > 0.f ? 7.0f / clip : 0.f;
#pragma unroll
            for (int j = 0; j < 4; ++j) {
                unsigned w = 0;
#pragma unroll
                for (int c = 0; c < 4; ++c) { const int qv = (int)fminf(fmaxf(rintf(v[j][c] * inv4), -7.0f), 7.0f); w |= (up ? (unsigned)(qv + 8) : ((unsigned)qv & 0xfu)) << (8 * c); }
                const unsigned pw = (unsigned)__builtin_amdgcn_update_dpp(0, (int)w, 0x4E, 0xF, 0xF, false);
                if ((lane & 2) == 0) *(GAS unsigned*)(ws + (up ? WS_UP8 : WS_DOWN8) + ((size_t)j * PEER_E + e) * 128 + (lane >> 2) * 8 + (lane & 1) * 4) = w | (pw << 4);
            }
            if (lane == 0) ((float*)(ws + (up ? WS_SU : WS_SD)))[e] = clip * (1.0f / 7.0f);
        }
    }
    }
    {
    __syncthreads();
    constexpr int GP = 1032;
    constexpr int XSP = 2080;
    LAS bf16* GWB = (LAS bf16*)lds;
    LAS unsigned char* XST = lds + 33280 + wave * (4 * XSP);
    for (int i = 0; i < 32; ++i) { const int idx = tid + NTHR * i, k = idx >> 4, j = idx & 15; GWB[j * GP + k] = (bf16)f2bf(P.w_in[(size_t)k * INW + INW_MAIN + j] * P.norm1_gain[k]); }
    __syncthreads();
    {
        f32x4 xn[4];
        { const f32x4* xr = (const f32x4*)(P.x + (size_t)(gw < T ? gw : 0) * DM) + lane;
#pragma unroll
          for (int j = 0; j < 4; ++j) xn[j] = xr[64 * j]; }
        for (int mb = gw; mb < T; mb += 4 * NGW) {
#pragma unroll
        for (int ri = 0; ri < 4; ++ri) { const int m = mb + ri * NGW; if (m < T) {
            f32x4 v[4]; float ss = 0.f;
#pragma unroll
            for (int j = 0; j < 4; ++j) { v[j] = xn[j]; ss += (v[j][0] * v[j][0] + v[j][1] * v[j][1]) + (v[j][2] * v[j][2] + v[j][3] * v[j][3]); }
            { const int mn = m + NGW; const f32x4* xr = (const f32x4*)(P.x + (size_t)(mn < T ? mn : m) * DM) + lane;
#pragma unroll
              for (int j = 0; j < 4; ++j) xn[j] = xr[64 * j]; }
            const float rr1 = sqrtf(wave_sum(ss) * (1.0f / DM) + NORM_EPS), r1 = 1.0f / rr1;
            if (lane == 0) ((float*)(ws + WS_RR))[m] = rr1;
#pragma unroll
            for (int j = 0; j < 4; ++j) { v[j] = v[j] * r1; v2u w; w.x = pk2(v[j][0], v[j][1]); w.y = pk2(v[j][2], v[j][3]); *(LAS v2u*)(XST + ri * XSP + (lane + 64 * j) * 8) = w; }
            {
                float am = 0.f;
#pragma unroll
                for (int j = 0; j < 4; ++j) am = fmaxf(am, fmaxf(fmaxf(fabsf(v[j][0]), fabsf(v[j][1])), fmaxf(fabsf(v[j][2]), fabsf(v[j][3]))));
                am = wave_max(am); const float qa = am > 0.f ? 127.0f / am : 0.f;
                if (lane == 0) ((float*)(ws + WS_SA))[m] = am * (1.0f / 127.0f);
#pragma unroll
                for (int j = 0; j < 4; ++j) ((GAS unsigned*)(ws + WS_XA8 + (size_t)m * DM))[lane + 64 * j] = pk4_i8(v[j][0] * qa, v[j][1] * qa, v[j][2] * qa, v[j][3] * qa); }
        } }
        LDS_WAIT(); asm volatile("" ::: "memory");
        {
            const int r = lane & 15, q = lane >> 4;
            const LAS unsigned char* ap = XST + (r & 3) * XSP + q * 16;
            f32x4 acc = {0.f, 0.f, 0.f, 0.f};
#pragma unroll
            for (int ks = 0; ks < 32; ++ks) { const bf16x8 afr = *(const LAS bf16x8*)(ap + ks * 64); const bf16x8 bfr = *(const LAS bf16x8*)(GWB + r * GP + ks * 32 + q * 8);
                acc = __builtin_amdgcn_mfma_f32_16x16x32_bf16(afr, bfr, acc, 0, 0, 0); }
            const int jg = lane & 15; const float gb = jg < 8 ? P.ml_igate_bias[jg] : P.ml_fgate_bias[jg - 8];
            if (q == 0) {
#pragma unroll
                for (int reg = 0; reg < 4; ++reg) { const int mm = mb + reg * NGW; if (mm < T) {
                    const float z = acc[reg] + gb;
                    if (jg < 8) ((float*)(ws + WS_LOGI))[(size_t)mm * 8 + jg] = z;
                    else ((float*)(ws + WS_LOGF))[(size_t)mm * 8 + jg - 8] = fminf(z, 0.f) - log1pf(expf(-fabsf(z))); } }
            }
            LDS_WAIT(); asm volatile("" ::: "memory");
        }
        }
    }
}
}

__device__ __forceinline__ void p2_vt(const Ptrs& P, int vcu, int G) {
    FRESH_TID();
    const int gw = vcu * NWAVES + wave, NGW = G * NWAVES;
    unsigned char* ws = P.ws;
    for (int it = gw; it < BATCH * 2 * (SEQ / 64); it += NGW) {
        const int b = it >> 8, kvh = (it >> 7) & 1, t = it & 127;
        const unsigned short* src = (const unsigned short*)(ws + WS_AV) + ((size_t)b * SEQ + t * 64) * 128 + kvh * 64 + lane;
#pragma unroll
        for (int c = 0; c < 4; ++c) {
            float v[16];
#pragma unroll
            for (int j = 0; j < 16; ++j) { const int sl = 16 * c + j, hi = sl >> 5, jj = sl & 31, r = jj & 15, key = (r & 3) + 8 * (r >> 2) + 4 * hi + (jj >> 4) * 32;
                v[j] = fminf(fmaxf(__builtin_bit_cast(float, (unsigned)src[(size_t)key * 128] << 16), -448.0f), 448.0f); }
            v4u o;
            { int w = 0; w = __builtin_amdgcn_cvt_pk_fp8_f32(v[0], v[1], w, false); w = __builtin_amdgcn_cvt_pk_fp8_f32(v[2], v[3], w, true); o.x = (unsigned)w; }
            { int w = 0; w = __builtin_amdgcn_cvt_pk_fp8_f32(v[4], v[5], w, false); w = __builtin_amdgcn_cvt_pk_fp8_f32(v[6], v[7], w, true); o.y = (unsigned)w; }
            { int w = 0; w = __builtin_amdgcn_cvt_pk_fp8_f32(v[8], v[9], w, false); w = __builtin_amdgcn_cvt_pk_fp8_f32(v[10], v[11], w, true); o.z = (unsigned)w; }
            { int w = 0; w = __builtin_amdgcn_cvt_pk_fp8_f32(v[12], v[13], w, false); w = __builtin_amdgcn_cvt_pk_fp8_f32(v[14], v[15], w, true); o.w = (unsigned)w; }
            *(GAS v4u*)(ws + WS_AV8T + ((size_t)it * 64 + lane) * 64 + c * 16) = o;
        }
    }
}

__device__ __forceinline__ void p2_rows(const Ptrs& P, int vcu, int G) {
    FRESH_TID();
    const int gw = vcu * NWAVES + wave, NGW = G * NWAVES;
    unsigned char* ws = P.ws;
    const int l7 = lane & 7, d0 = l7 * 8;
    float invf[4];
#pragma unroll
    for (int p = 0; p < 4; ++p) invf[p] = exp2f(-(float)((l7 & 3) * 4 + p) * (13.287712379549449f / 16.0f));
    float gk[8];
#pragma unroll
    for (int e = 0; e < 8; ++e) gk[e] = P.att_k_gain[d0 + e];
    for (int m4 = gw * 4; m4 < T; m4 += NGW * 4) {
        const int m = m4 + (lane >> 4);
        const int pos = m & (SEQ - 1);
        const float pid = (l7 < 4) ? (float)(pos >> 6) : (float)(pos & 63);
        float cs[4], sn[4];
#pragma unroll
        for (int p = 0; p < 4; ++p) { float rev = pid * invf[p] * 0.15915494309189535f; rev -= floorf(rev); sn[p] = __builtin_amdgcn_sinf(rev); cs[p] = __builtin_amdgcn_cosf(rev); }
        GAS v4u* kp = (GAS v4u*)(ws + WS_AK + (size_t)m * 128 * 2) + (lane & 15);
        const v4u raw = *kp; float f[8];
        f[0] = bflo(raw.x); f[1] = bfhi(raw.x); f[2] = bflo(raw.y); f[3] = bfhi(raw.y); f[4] = bflo(raw.z); f[5] = bfhi(raw.z); f[6] = bflo(raw.w); f[7] = bfhi(raw.w);
        float ss = 0.f;
#pragma unroll
        for (int e = 0; e < 8; ++e) ss += f[e] * f[e];
        ss += __shfl_xor(ss, 1); ss += __shfl_xor(ss, 2); ss += __shfl_xor(ss, 4);
        const float rs = 1.0f / sqrtf(ss * (1.0f / 64.0f) + NORM_EPS);
#pragma unroll
        for (int e = 0; e < 8; ++e) f[e] = f[e] * rs * gk[e];
        float rt[8];
#pragma unroll
        for (int p = 0; p < 4; ++p) { rt[2 * p] = f[2 * p] * cs[p] - f[2 * p + 1] * sn[p]; rt[2 * p + 1] = f[2 * p] * sn[p] + f[2 * p + 1] * cs[p]; }
#pragma unroll
        for (int e = 0; e < 8; ++e) rt[e] = fminf(fmaxf(rt[e], -448.0f), 448.0f);
        int w0 = 0, w1 = 0;
        w0 = __builtin_amdgcn_cvt_pk_fp8_f32(rt[0], rt[1], w0, false); w0 = __builtin_amdgcn_cvt_pk_fp8_f32(rt[2], rt[3], w0, true);
        w1 = __builtin_amdgcn_cvt_pk_fp8_f32(rt[4], rt[5], w1, false); w1 = __builtin_amdgcn_cvt_pk_fp8_f32(rt[6], rt[7], w1, true);
        v2u o; o.x = (unsigned)w0; o.y = (unsigned)w1;
        *((GAS v2u*)(ws + WS_AK8 + (size_t)m * 128) + (lane & 15)) = o;
    }
}

__device__ __forceinline__ void tr_store2(LAS bf16* DT, int c0, int s, const v4u ra, const v4u rb) {
    LAS unsigned* p = (LAS unsigned*)(DT + c0 * TPITCH + s);
    const unsigned a[4] = {ra.x, ra.y, ra.z, ra.w}, b[4] = {rb.x, rb.y, rb.z, rb.w};
#pragma unroll
    for (int j = 0; j < 4; ++j) { p[(2 * j) * (TPITCH / 2)] = (a[j] & 0xffffu) | (b[j] << 16); p[(2 * j + 1) * (TPITCH / 2)] = (a[j] >> 16) | (b[j] & 0xffff0000u); }
}
__device__ __forceinline__ void unpack8(const v4u r, float (&f)[8]) {
    f[0] = bflo(r.x); f[1] = bfhi(r.x); f[2] = bflo(r.y); f[3] = bfhi(r.y); f[4] = bflo(r.z); f[5] = bfhi(r.z); f[6] = bflo(r.w); f[7] = bfhi(r.w);
}

__device__ __forceinline__ void conv_chunk_to_lds(const Ptrs& P, const bf16* src, int which, int h, int c, size_t t0, LAS bf16* DST, int tid) {
    const int cg = tid & 15, ch0 = which * 512 + h * 128 + cg * 8;
    float w0[8], w1[8], w2[8], cb[8];
#pragma unroll
    for (int e = 0; e < 8; ++e) { w0[e] = P.ml_conv_w[ch0 + e]; w1[e] = P.ml_conv_w[1024 + ch0 + e]; w2[e] = P.ml_conv_w[2048 + ch0 + e]; cb[e] = P.ml_conv_b[ch0 + e]; }
    v4u r0[4], r1[4], r2[4];
#pragma unroll
    for (int it = 0; it < 4; ++it) {
        const int rr = (tid >> 4) + 32 * it; const int pos = c * CHL + rr; const size_t off = (t0 + rr) * 512 + h * 128 + cg * 8;
        const v4u z4 = {0u, 0u, 0u, 0u};
        r1[it] = *(const v4u*)(src + off);
        r0[it] = (pos > 0) ? *(const v4u*)(src + off - 512) : z4;
        r2[it] = (pos < SEQ - 1) ? *(const v4u*)(src + off + 512) : z4;
    }
#pragma unroll
    for (int it = 0; it < 4; ++it) {
        const int rr = (tid >> 4) + 32 * it;
        float x0[8], x1[8], x2[8], y[8]; unpack8(r0[it], x0); unpack8(r1[it], x1); unpack8(r2[it], x2);
#pragma unroll
        for (int e = 0; e < 8; ++e) { float v = w0[e] * x0[e] + w1[e] * x1[e] + w2[e] * x2[e] + cb[e]; v = v * fsigmoid(v); y[e] = which ? v * 0.08838834764831845f : v; }
        v4u o; o.x = pk2(y[0], y[1]); o.y = pk2(y[2], y[3]); o.z = pk2(y[4], y[5]); o.w = pk2(y[6], y[7]);
        *(LAS v4u*)(DST + rr * TPITCH + cg * 8) = o;
    }
}
__device__ __forceinline__ void p2_mlstm_item(const Ptrs& P, LAS unsigned char* lds, int item) {
    FRESH_TID();
    unsigned char* ws = P.ws;
    const int b = item >> 8, h = (item >> 6) & 3, c = item & 63;
    const size_t t0 = (size_t)b * SEQ + (size_t)c * CHL;
    LAS bf16* KS = (LAS bf16*)lds; LAS bf16* VT = (LAS bf16*)(lds + TILE_B); LAS bf16* KWT = (LAS bf16*)(lds + 2 * TILE_B); LAS float* WV = (LAS float*)(lds + 3 * TILE_B);
    conv_chunk_to_lds(P, (const bf16*)(ws + WS_MK), 1, h, c, t0, KS, tid);
    {
    if (wave < 2) {
        const int dir = wave, s0 = 2 * lane; const int chain = ((b * MLH + h) << 1) | dir;
        const float* LI = (const float*)(ws + WS_LOGI); const float* LF = (const float*)(ws + WS_LOGF);
        const float li0 = LI[(t0 + s0) * 8 + dir * 4 + h], li1 = LI[(t0 + s0 + 1) * 8 + dir * 4 + h];
        const float lf0 = LF[(t0 + s0) * 8 + dir * 4 + h], lf1 = LF[(t0 + s0 + 1) * 8 + dir * 4 + h];
        const float Pf = wave_incl_add(lf0 + lf1, lane), tot = __shfl(Pf, 63);
        float cum0, cum1;
        if (dir == 0) { cum0 = Pf - lf1; cum1 = Pf; } else { cum0 = tot - (Pf - lf1) + lf0; cum1 = tot - Pf + lf1; }
        const float a0 = tot - cum0 + li0, a1 = tot - cum1 + li1;
        const float mloc = wave_max(fmaxf(a0, a1));
        WV[dir * 128 + s0] = fexp(a0 - mloc); WV[dir * 128 + s0 + 1] = fexp(a1 - mloc);
        if (lane == 0) { float* SC = (float*)(ws + WS_SCAL) + (size_t)(chain * NCHUNK + c) * 2; SC[0] = tot; SC[1] = mloc; }
    }
#pragma unroll
    for (int it = 0; it < 2; ++it) { const int idx = tid + NTHR * it, sp2 = (idx & 63) * 2, eg = idx >> 6;
        const bf16* src = (const bf16*)(ws + WS_MV) + (t0 + sp2) * 512 + h * 128 + eg * 8;
        tr_store2(VT, eg * 8, sp2, *(const v4u*)src, *(const v4u*)(src + 512)); }
    }
    __syncthreads();
    for (int dir = 0; dir < 2; ++dir) {
        const int chain = ((b * MLH + h) << 1) | dir; const size_t itx = (size_t)chain * NCHUNK + c;
#pragma unroll
        for (int it = 0; it < 2; ++it) { const int idx = tid + NTHR * it, sp2 = (idx & 63) * 2, dg = idx >> 6;
            const v4u ra = *(const LAS v4u*)(KS + sp2 * TPITCH + dg * 8), rb = *(const LAS v4u*)(KS + (sp2 + 1) * TPITCH + dg * 8);
            const float wa = WV[dir * 128 + sp2], wb = WV[dir * 128 + sp2 + 1]; float fa[8], fb[8]; unpack8(ra, fa); unpack8(rb, fb);
            v4u qa, qb;
            qa.x = pk2(fa[0] * wa, fa[1] * wa); qa.y = pk2(fa[2] * wa, fa[3] * wa); qa.z = pk2(fa[4] * wa, fa[5] * wa); qa.w = pk2(fa[6] * wa, fa[7] * wa);
            qb.x = pk2(fb[0] * wb, fb[1] * wb); qb.y = pk2(fb[2] * wb, fb[3] * wb); qb.z = pk2(fb[4] * wb, fb[5] * wb); qb.w = pk2(fb[6] * wb, fb[7] * wb);
            tr_store2(KWT, dg * 8, sp2, qa, qb); }
        { const int d = tid & 127, part = tid >> 7; float a = 0.f;
#pragma unroll 8
          for (int s2 = part * 32; s2 < part * 32 + 32; ++s2) a += WV[dir * 128 + s2] * bf2f(KS[s2 * TPITCH + d]);
          WV[256 + part * 128 + d] = a; }
        __syncthreads();
        if (tid < 128) ((float*)(ws + WS_DN))[itx * 128 + tid] = (WV[256 + tid] + WV[384 + tid]) + (WV[512 + tid] + WV[640 + tid]);
        __syncthreads();
        f32x4 acc[8];
#pragma unroll
        for (int nt = 0; nt < 8; ++nt) acc[nt] = (f32x4){0.f, 0.f, 0.f, 0.f};
        wave_gemm<128>(KWT, wave * 16, VT, acc, lane);
        bf16* CS = (bf16*)(ws + WS_CST) + itx * 16384;
#pragma unroll
        for (int nt = 0; nt < 8; ++nt) { v2u o; o.x = pk2(acc[nt][0], acc[nt][1]); o.y = pk2(acc[nt][2], acc[nt][3]);
            *(v2u*)(CS + (nt * 16 + (lane & 15)) * 128 + wave * 16 + (lane >> 4) * 4) = o; }
        __syncthreads();
    }
}

__device__ __forceinline__ void p3_scan(const Ptrs& P, LAS unsigned char* lds, int vcu, int G) {
    FRESH_TID();
    unsigned char* ws = P.ws;
    const float* SC = (const float*)(ws + WS_SCAL); float* MP = (float*)(ws + WS_MPREV);
    LAS float* BT = (LAS float*)lds; LAS float* ML = BT + 64; LAS float* AL = BT + 128; LAS float* BE = BT + 192; LAS float* MPV = BT + 256;
    for (int u = vcu; u < 256; u += G) {
        const int chain = u >> 3, seg = u & 7, dir = chain & 1;
        __syncthreads();
        if (tid < 64) { const int c = dir ? (NCHUNK - 1 - tid) : tid; const size_t itx = (size_t)chain * NCHUNK + c; BT[tid] = SC[itx * 2]; ML[tid] = SC[itx * 2 + 1]; }
        __syncthreads();
        if (tid == 0) { float m = 0.f;
            for (int st = 0; st < NCHUNK; ++st) { const float btot = BT[st], mloc = ML[st]; const float mnew = fmaxf(btot + m, mloc); MPV[st] = m; AL[st] = fexp(btot + m - mnew); BE[st] = fexp(mloc - mnew); m = mnew; } }
        __syncthreads();
        {
            bf16* base = (bf16*)(ws + WS_CST) + (size_t)chain * NCHUNK * 16384 + seg * 2048 + tid * 4;
            float C0 = 0.f, C1 = 0.f, C2 = 0.f, C3 = 0.f;
#pragma unroll 1
            for (int half = 0; half < 2; ++half) {
                v2u d[32];
#pragma unroll
                for (int k = 0; k < 32; ++k) { const int st = half * 32 + k, c = dir ? (NCHUNK - 1 - st) : st; d[k] = *(const v2u*)(base + (size_t)c * 16384); }
#pragma unroll
                for (int k = 0; k < 32; ++k) { const int st = half * 32 + k, c = dir ? (NCHUNK - 1 - st) : st;
                    v2u o; o.x = pk2(C0, C1); o.y = pk2(C2, C3); *(v2u*)(base + (size_t)c * 16384) = o;
                    const float al = AL[st], be = BE[st];
                    C0 = al * C0 + be * bflo(d[k].x); C1 = al * C1 + be * bfhi(d[k].x); C2 = al * C2 + be * bflo(d[k].y); C3 = al * C3 + be * bfhi(d[k].y); }
            }
            if (seg == 0 && tid < 64) { const int c = dir ? (NCHUNK - 1 - tid) : tid; MP[(size_t)chain * NCHUNK + c] = MPV[tid]; }
        }
        if (seg == 0 && tid < 128) {
            float* base = (float*)(ws + WS_DN) + (size_t)chain * NCHUNK * 128 + tid;
            float n = 0.f;
#pragma unroll 1
            for (int half = 0; half < 2; ++half) {
                float d[32];
#pragma unroll
                for (int k = 0; k < 32; ++k) { const int st = half * 32 + k, c = dir ? (NCHUNK - 1 - st) : st; d[k] = base[(size_t)c * 128]; }
#pragma unroll
                for (int k = 0; k < 32; ++k) { const int st = half * 32 + k, c = dir ? (NCHUNK - 1 - st) : st; base[(size_t)c * 128] = n; n = AL[st] * n + BE[st] * d[k]; }
            }
        }
    }
    __syncthreads();
}

__device__ __forceinline__ void p4_mlstm_item(const Ptrs& P, LAS unsigned char* lds, int item) {
    FRESH_TID();
    unsigned char* ws = P.ws;
    const int b = item >> 8, h = (item >> 6) & 3, c = item & 63;
    const size_t t0 = (size_t)b * SEQ + (size_t)c * CHL;
    LAS bf16* QS = (LAS bf16*)lds; LAS bf16* KS = (LAS bf16*)(lds + TILE_B); LAS bf16* VT = (LAS bf16*)(lds + 2 * TILE_B); LAS bf16* CT = (LAS bf16*)(lds + 3 * TILE_B);
    LAS bf16* SP = KS;
    LAS float* ARR = (LAS float*)(lds + 4 * TILE_B);
    const int fr = lane & 15, fq = lane >> 4, l0 = wave * 16;
    const size_t itx0 = (size_t)(((b * MLH + h) << 1) | 0) * NCHUNK + c, itx1 = (size_t)(((b * MLH + h) << 1) | 1) * NCHUNK + c;
    conv_chunk_to_lds(P, (const bf16*)(ws + WS_MQ), 0, h, c, t0, QS, tid);
    conv_chunk_to_lds(P, (const bf16*)(ws + WS_MK), 1, h, c, t0, KS, tid);
    v4u ct1[4];
#pragma unroll
    for (int it = 0; it < 4; ++it) { const int idx = tid + NTHR * it, e = idx >> 4, dg = idx & 15; ct1[it] = *(const v4u*)((const bf16*)(ws + WS_CST) + itx1 * 16384 + e * 128 + dg * 8); }
#pragma unroll
    for (int it = 0; it < 4; ++it) { { const int idx = tid + NTHR * it, s = idx >> 4, eg = idx & 15; const size_t off = (t0 + s) * 512 + h * 128 + eg * 8;
        *(LAS v4u*)(CT + s * TPITCH + eg * 8) = *(const v4u*)((const bf16*)(ws + WS_CST) + itx0 * 16384 + s * 128 + eg * 8); }
    }
#pragma unroll
    for (int it = 0; it < 2; ++it) { const int idx = tid + NTHR * it, sp2 = (idx & 63) * 2, eg = idx >> 6;
        const bf16* src = (const bf16*)(ws + WS_MV) + (t0 + sp2) * 512 + h * 128 + eg * 8;
        tr_store2(VT, eg * 8, sp2, *(const v4u*)src, *(const v4u*)(src + 512)); }
    if (tid >= 128 && tid < 384) { const int d = (tid - 128) >> 7, j = (tid - 128) & 127; ARR[d * 896 + 768 + j] = ((const float*)(ws + WS_DN))[(d ? itx1 : itx0) * 128 + j]; }
    if (wave < 2) {
        const int dir = wave, s0 = 2 * lane; LAS float* A = ARR + dir * 896;
        const float* LI = (const float*)(ws + WS_LOGI); const float* LF = (const float*)(ws + WS_LOGF);
        const float li0 = LI[(t0 + s0) * 8 + dir * 4 + h], li1 = LI[(t0 + s0 + 1) * 8 + dir * 4 + h];
        const float lf0 = LF[(t0 + s0) * 8 + dir * 4 + h], lf1 = LF[(t0 + s0 + 1) * 8 + dir * 4 + h];
        const float mp = ((const float*)(ws + WS_MPREV))[dir ? itx1 : itx0];
        const float Pf = wave_incl_add(lf0 + lf1, lane), tot = __shfl(Pf, 63);
        float cum0, cum1, pm0, pm1;
        if (dir == 0) { cum0 = Pf - lf1; cum1 = Pf; } else { cum0 = tot - (Pf - lf1) + lf0; cum1 = tot - Pf + lf1; }
        const float g0 = li0 - cum0, g1 = li1 - cum1;
        if (dir == 0) { const float PM = wave_incl_max(fmaxf(g0, g1), lane); float px = __shfl_up(PM, 1); if (lane == 0) px = -INFINITY; pm0 = fmaxf(px, g0); pm1 = PM; }
        else { const float PM = wave_incl_max_rev(fmaxf(g0, g1), lane); float px = __shfl_down(PM, 1); if (lane == 63) px = -INFINITY; pm1 = fmaxf(px, g1); pm0 = PM; }
        const float mr0 = cum0 + fmaxf(mp, pm0), mr1 = cum1 + fmaxf(mp, pm1);
        A[s0] = cum0; A[s0 + 1] = cum1; A[128 + s0] = li0; A[128 + s0 + 1] = li1; A[256 + s0] = mr0; A[256 + s0 + 1] = mr1;
        A[384 + s0] = fexp(cum0 + mp - mr0); A[384 + s0 + 1] = fexp(cum1 + mp - mr1); A[512 + s0] = fexp(-mr0); A[512 + s0 + 1] = fexp(-mr1);
    }
    __syncthreads();
    {
        const int l = tid >> 2, part = tid & 3; float a0 = 0.f, a1 = 0.f;
#pragma unroll
        for (int j = 0; j < 4; ++j) { const v4u r = *(const LAS v4u*)(QS + l * TPITCH + part * 32 + j * 8); float f[8]; unpack8(r, f);
#pragma unroll
            for (int e = 0; e < 8; ++e) { a0 += f[e] * ARR[768 + part * 32 + j * 8 + e]; a1 += f[e] * ARR[896 + 768 + part * 32 + j * 8 + e]; } }
        a0 += __shfl_xor(a0, 1); a0 += __shfl_xor(a0, 2); a1 += __shfl_xor(a1, 1); a1 += __shfl_xor(a1, 2);
        if (part == 0) { ARR[640 + l] = a0; ARR[896 + 640 + l] = a1; }
    }
    f32x4 S[8], hs[8], acc[8];
#pragma unroll
    for (int nt = 0; nt < 8; ++nt) { S[nt] = (f32x4){0.f, 0.f, 0.f, 0.f}; acc[nt] = (f32x4){0.f, 0.f, 0.f, 0.f}; }
    wave_gemm<128>(QS, l0, KS, S, lane);
    wave_gemm<128>(QS, l0, CT, acc, lane);
    __syncthreads();
#pragma unroll
    for (int it = 0; it < 4; ++it) { const int idx = tid + NTHR * it, e = idx >> 4, dg = idx & 15; *(LAS v4u*)(CT + e * TPITCH + dg * 8) = ct1[it]; }
#pragma unroll
    for (int dir = 0; dir < 2; ++dir) {
        const LAS float* A = ARR + dir * 896;
        float dint[4] = {0.f, 0.f, 0.f, 0.f};
        float ul[4];
#pragma unroll
        for (int r = 0; r < 4; ++r) { const int l = l0 + fq * 4 + r; ul[r] = (A[l] - A[256 + l]) * 1.4426950408889634f; }
#pragma unroll
        for (int nt = 0; nt < 8; ++nt) {
            const int sx = nt * 16 + fr;
            const bool full = dir ? (nt > wave) : (nt < wave), diag = (nt == wave);
            const bool wanted = dir ? (nt >= (wave & ~1)) : (nt <= (wave | 1));
            if (full || diag) {
                const float gs = (A[128 + sx] - A[sx]) * 1.4426950408889634f;
                float sp[4];
#pragma unroll
                for (int r = 0; r < 4; ++r) { const int l = l0 + fq * 4 + r; float wgt = __builtin_amdgcn_exp2f(ul[r] + gs);
                    if (diag) wgt = (dir ? (sx >= l) : (sx <= l)) ? wgt : 0.f;
                    sp[r] = S[nt][r] * wgt; dint[r] += sp[r]; }
                const unsigned p01 = pk2(sp[0], sp[1]), p23 = pk2(sp[2], sp[3]);
                SP[(l0 + fq * 4 + 0) * TPITCH + sx] = (bf16)(p01 & 0xffffu); SP[(l0 + fq * 4 + 1) * TPITCH + sx] = (bf16)(p01 >> 16);
                SP[(l0 + fq * 4 + 2) * TPITCH + sx] = (bf16)(p23 & 0xffffu); SP[(l0 + fq * 4 + 3) * TPITCH + sx] = (bf16)(p23 >> 16);
            } else if (wanted) {
#pragma unroll
                for (int r = 0; r < 4; ++r) SP[(l0 + fq * 4 + r) * TPITCH + sx] = (bf16)0;
            }
        }
#pragma unroll
        for (int r = 0; r < 4; ++r) { dint[r] += __shfl_xor(dint[r], 1); dint[r] += __shfl_xor(dint[r], 2); dint[r] += __shfl_xor(dint[r], 4); dint[r] += __shfl_xor(dint[r], 8); }
        if (dir == 1) {
            __syncthreads();
#pragma unroll
            for (int nt = 0; nt < 8; ++nt) acc[nt] = (f32x4){0.f, 0.f, 0.f, 0.f};
            wave_gemm<128>(QS, l0, CT, acc, lane);
        }
        float wi[4], dn[4];
#pragma unroll
        for (int r = 0; r < 4; ++r) { const int l = l0 + fq * 4 + r; wi[r] = A[384 + l]; const float den = wi[r] * A[640 + l] + dint[r]; dn[r] = 1.0f / fmaxf(fabsf(den), A[512 + l]); }
#pragma unroll
        for (int nt = 0; nt < 8; ++nt)
#pragma unroll
            for (int r = 0; r < 4; ++r) acc[nt][r] *= wi[r];
        asm volatile("s_waitcnt lgkmcnt(0)" ::: "memory");
        {
            const int kh = wave >> 1;
#pragma unroll
            for (int ks = 0; ks < 4; ++ks) {
                if (dir ? (ks >= kh) : (ks <= kh)) {
                    const bf16x8 a = *(const LAS bf16x8*)(SP + (l0 + fr) * TPITCH + ks * 32 + fq * 8);
#pragma unroll
                    for (int nt = 0; nt < 8; ++nt) { const bf16x8 bb = *(const LAS bf16x8*)(VT + (nt * 16 + fr) * TPITCH + ks * 32 + fq * 8); acc[nt] = __builtin_amdgcn_mfma_f32_16x16x32_bf16(a, bb, acc[nt], 0, 0, 0); }
                }
            }
        }
#pragma unroll
        for (int nt = 0; nt < 8; ++nt)
#pragma unroll
            for (int r = 0; r < 4; ++r) hs[nt][r] = (dir ? hs[nt][r] : 0.f) + acc[nt][r] * dn[r];
    }
    float rs[4];
#pragma unroll
    for (int r = 0; r < 4; ++r) { float ss = 0.f;
#pragma unroll
        for (int nt = 0; nt < 8; ++nt) ss += hs[nt][r] * hs[nt][r];
        ss += __shfl_xor(ss, 1); ss += __shfl_xor(ss, 2); ss += __shfl_xor(ss, 4); ss += __shfl_xor(ss, 8);
        rs[r] = 1.0f / sqrtf(ss * (1.0f / 128.0f) + NORM_EPS); }
#pragma unroll
    for (int nt = 0; nt < 8; ++nt) { const int e = nt * 16 + fr; const float og = P.ml_out_gain[h * 128 + e];
#pragma unroll
        for (int r = 0; r < 4; ++r) { const size_t t = t0 + l0 + fq * 4 + r;
            const float o = bf2f(((const bf16*)(ws + WS_MO))[t * 512 + h * 128 + e]);
            const float val = hs[nt][r] * rs[r] * og * fsigmoid(o);
            { int w8 = 0; w8 = __builtin_amdgcn_cvt_pk_fp8_f32(fminf(fmaxf(val * MIX8SCALE, -448.f), 448.f), 0.f, w8, false); (ws + WS_MIX)[t * 1024 + 512 + h * 128 + e] = (unsigned char)(w8 & 0xff); } } }
    __syncthreads();
}

__device__ __forceinline__ int dpp_xor1i(int x) { return __builtin_amdgcn_update_dpp(0, x, 0xB1, 0xF, 0xF, false); }
__device__ __forceinline__ int dpp_xor2i(int x) { return __builtin_amdgcn_update_dpp(0, x, 0x4E, 0xF, 0xF, false); }
__device__ __forceinline__ int swz_xor4i(int x) { return __builtin_amdgcn_ds_swizzle(x, 0x101F); }
__device__ __forceinline__ int dpp_ror8i(int x) { return __builtin_amdgcn_update_dpp(0, x, 0x128, 0xF, 0xF, false); }
__device__ __forceinline__ float key2val(unsigned key) { unsigned o = key >> 16; unsigned b = (o & 0x8000u) ? (o & 0x7fffu) : (~o & 0xffffu); _Float16 hv = __builtin_bit_cast(_Float16, (unsigned short)b); return (float)hv; }
__device__ __forceinline__ unsigned umax2(unsigned a, unsigned b) { return a > b ? a : b; }
__device__ __forceinline__ unsigned umin2(unsigned a, unsigned b) { return a > b ? b : a; }
__device__ __forceinline__ void sort16_desc(unsigned (&a)[16]) {
#pragma unroll
    for (int k = 2; k <= 16; k <<= 1)
#pragma unroll
        for (int j = k >> 1; j > 0; j >>= 1)
#pragma unroll
            for (int i = 0; i < 16; ++i) { const int l = i ^ j; if (l > i) { const unsigned hi = umax2(a[i], a[l]), lo = umin2(a[i], a[l]); const bool desc = (k == 16) || ((i & k) == 0); a[i] = desc ? hi : lo; a[l] = desc ? lo : hi; } }
}
__device__ __forceinline__ void merge16_desc(unsigned (&top)[16], const unsigned (&blk)[16]) {
#pragma unroll
    for (int i = 0; i < 16; ++i) top[i] = umax2(top[i], blk[15 - i]);
#pragma unroll
    for (int j = 8; j > 0; j >>= 1)
#pragma unroll
        for (int i = 0; i < 16; ++i) { const int l = i ^ j; if (l > i) { const unsigned hi = umax2(top[i], top[l]), lo = umin2(top[i], top[l]); top[i] = hi; top[l] = lo; } }
}
__device__ __forceinline__ void topk_half(const unsigned short* sc, unsigned (&v)[16]) {
#pragma unroll 1
    for (int blk = 0; blk < 8; ++blk) {
        const v4u r0 = *(const v4u*)(sc + (2 * blk) * 512), r1 = *(const v4u*)(sc + (2 * blk + 1) * 512);
        const unsigned w[8] = {r0.x, r0.y, r0.z, r0.w, r1.x, r1.y, r1.z, r1.w};
        unsigned b[16];
        const unsigned base = 127u - 16u * (unsigned)blk;
#pragma unroll
        for (int e = 0; e < 8; ++e) { b[2 * e] = (w[e] << 16) | (base - 2u * e); b[2 * e + 1] = (w[e] & 0xffff0000u) | (base - 2u * e - 1u); }
        sort16_desc(b);
        if (blk == 0) {
#pragma unroll
            for (int p = 0; p < 16; ++p) v[p] = b[p];
        } else merge16_desc(v, b);
    }
}
__device__ __forceinline__ unsigned ordf(float s) { const unsigned sb = __builtin_bit_cast(unsigned, s); return (sb & 0x80000000u) ? ~sb : (sb | 0x80000000u); }
__device__ __forceinline__ void p7_topk(const Ptrs& P, LAS unsigned char* lds, int vcu, int G) {
    FRESH_TID();
    unsigned char* ws = P.ws;
    LAS unsigned char* myl = lds + tid * 36;
    for (int t = vcu * NWAVES + wave; t < T; t += G * NWAVES) {
        const v4u* hp = (const v4u*)((const bf16*)(ws + WS_HB) + (size_t)t * DM + 16 * lane);
        const v4u ha = hp[0], hb = hp[1];
        float f[16];
        f[0] = bflo(ha.x); f[1] = bfhi(ha.x); f[2] = bflo(ha.y); f[3] = bfhi(ha.y); f[4] = bflo(ha.z); f[5] = bfhi(ha.z); f[6] = bflo(ha.w); f[7] = bfhi(ha.w);
        f[8] = bflo(hb.x); f[9] = bfhi(hb.x); f[10] = bflo(hb.y); f[11] = bfhi(hb.y); f[12] = bflo(hb.z); f[13] = bfhi(hb.z); f[14] = bflo(hb.w); f[15] = bfhi(hb.w);
        float hm = 0.f;
#pragma unroll
        for (int e = 0; e < 16; ++e) hm = fmaxf(hm, fabsf(f[e]));
        hm = fmaxf(hm, __builtin_bit_cast(float, dpp_xor1i(__builtin_bit_cast(int, hm)))); hm = fmaxf(hm, __builtin_bit_cast(float, dpp_xor2i(__builtin_bit_cast(int, hm))));
        hm = fmaxf(hm, __builtin_bit_cast(float, swz_xor4i(__builtin_bit_cast(int, hm)))); hm = fmaxf(hm, __builtin_bit_cast(float, dpp_ror8i(__builtin_bit_cast(int, hm))));
        const float xs = hm > 0.f ? 119.0f / hm : 0.f;
        unsigned nh[16], nl[16];
#pragma unroll
        for (int e = 0; e < 16; ++e) { const int xi = (int)rintf(f[e] * xs); const int xh = (xi + 8) >> 4, xl = xi - 16 * xh; nh[e] = (unsigned)xh & 0xfu; nl[e] = (unsigned)xl & 0xfu; }
        v2u oh, ol;
        oh.x = (nh[0] | (nh[8] << 4)) | ((nh[1] | (nh[9] << 4)) << 8) | ((nh[2] | (nh[10] << 4)) << 16) | ((nh[3] | (nh[11] << 4)) << 24);
        oh.y = (nh[4] | (nh[12] << 4)) | ((nh[5] | (nh[13] << 4)) << 8) | ((nh[6] | (nh[14] << 4)) << 16) | ((nh[7] | (nh[15] << 4)) << 24);
        ol.x = (nl[0] | (nl[8] << 4)) | ((nl[1] | (nl[9] << 4)) << 8) | ((nl[2] | (nl[10] << 4)) << 16) | ((nl[3] | (nl[11] << 4)) << 24);
        ol.y = (nl[4] | (nl[12] << 4)) | ((nl[5] | (nl[13] << 4)) << 8) | ((nl[6] | (nl[14] << 4)) << 16) | ((nl[7] | (nl[15] << 4)) << 24);
        *(v2u*)(ws + WS_XQ + (size_t)t * DM + 8 * lane) = oh; *(v2u*)(ws + WS_XQ + (size_t)t * DM + 512 + 8 * lane) = ol;
        if ((lane & 15) == 0) ((float*)(ws + WS_XS))[(size_t)t * 4 + (lane >> 4)] = hm * (1.0f / 119.0f);
    }
    for (int wi = vcu * NWAVES + wave; wi < (T / 64) * 8; wi += G * NWAVES) {
        const int tb = wi >> 3, head = wi & 7; const int item = (tb * 64 + lane) * 8 + head;
        const unsigned short* sc = (const unsigned short*)(ws + WS_SC) + ((size_t)(tb * 16 + head * 2) * 16 * 64 + lane) * 8;
        unsigned ka[16], kb[16];
        topk_half(sc, ka); topk_half(sc + 16 * 64 * 8, kb);
        float av[16], bv[16];
#pragma unroll
        for (int i = 0; i < 16; ++i) { av[i] = key2val(ka[i]); bv[i] = key2val(kb[i]); }
#pragma unroll
        for (int q = 0; q < 4; ++q) {
            ((LAS unsigned*)myl)[q] = ((127u - (ka[4 * q] & 0x7fu))) | ((127u - (ka[4 * q + 1] & 0x7fu)) << 8) | ((127u - (ka[4 * q + 2] & 0x7fu)) << 16) | ((127u - (ka[4 * q + 3] & 0x7fu)) << 24);
            ((LAS unsigned*)myl)[4 + q] = ((127u - (kb[4 * q] & 0x7fu))) | ((127u - (kb[4 * q + 1] & 0x7fu)) << 8) | ((127u - (kb[4 * q + 2] & 0x7fu)) << 16) | ((127u - (kb[4 * q + 3] & 0x7fu)) << 24);
        }
#define CKEY(i, j) ((ordf(av[i] + bv[j]) & 0xffffff00u) | (255u - (unsigned)(16 * (i) + (j))))
        unsigned top[16], blk[16];
#pragma unroll
        for (int j = 0; j < 16; ++j) top[j] = CKEY(0, j);
#pragma unroll
        for (int j = 0; j < 16; ++j) blk[j] = 0u;
#pragma unroll
        for (int j = 0; j < 8; ++j) blk[j] = CKEY(1, j);
        merge16_desc(top, blk);
#pragma unroll
        for (int j = 0; j < 16; ++j) blk[j] = 0u;
#pragma unroll
        for (int j = 0; j < 5; ++j) blk[j] = CKEY(2, j);
        merge16_desc(top, blk);
#pragma unroll
        for (int j = 0; j < 16; ++j) blk[j] = 0u;
#pragma unroll
        for (int j = 0; j < 4; ++j) blk[j] = CKEY(3, j);
        merge16_desc(top, blk);
#pragma unroll
        for (int j = 0; j < 16; ++j) blk[j] = 0u;
#pragma unroll
        for (int j = 0; j < 3; ++j) blk[j] = CKEY(4, j);
        merge16_desc(top, blk);
        blk[0] = CKEY(5, 0); blk[1] = CKEY(5, 1); blk[2] = CKEY(6, 0); blk[3] = CKEY(6, 1); blk[4] = CKEY(7, 0); blk[5] = CKEY(7, 1);
        blk[6] = CKEY(8, 0); blk[7] = CKEY(9, 0); blk[8] = CKEY(10, 0); blk[9] = CKEY(11, 0); blk[10] = CKEY(12, 0); blk[11] = CKEY(13, 0); blk[12] = CKEY(14, 0); blk[13] = CKEY(15, 0); blk[14] = 0u; blk[15] = 0u;
        sort16_desc(blk);
        merge16_desc(top, blk);
#undef CKEY
        float sv[16]; float ssum = 0.f;
#pragma unroll
        for (int p = 0; p < 16; ++p) { const unsigned o = top[p] & 0xffffff00u; sv[p] = (o & 0x80000000u) ? __builtin_bit_cast(float, o & 0x7fffffffu) : __builtin_bit_cast(float, ~o & 0xffffff00u); }
        float r2;
        { const f32x4* sp = (const f32x4*)((const float*)(ws + WS_SSQ) + (size_t)(tb * 64 + lane) * 16);
          const f32x4 s0 = sp[0], s1 = sp[1], s2 = sp[2], s3 = sp[3];
          const float ss = ((s0[0] + s0[1]) + (s0[2] + s0[3])) + ((s1[0] + s1[1]) + (s1[2] + s1[3])) + ((s2[0] + s2[1]) + (s2[2] + s2[3])) + ((s3[0] + s3[1]) + (s3[2] + s3[3]));
          r2 = 1.0f / sqrtf(ss * (1.0f / DM) + NORM_EPS); }
        const float mx = sv[0];
#pragma unroll
        for (int p = 0; p < 16; ++p) { sv[p] = fexp((sv[p] - mx) * r2); ssum += sv[p]; }
        const float inv = 1.0f / ssum;
        asm volatile("s_waitcnt lgkmcnt(0)" ::: "memory");
        unsigned short* IDS = (unsigned short*)(ws + WS_IDS) + (size_t)item * 16; float* GT = (float*)(ws + WS_GATES) + (size_t)item * 16;
        unsigned idw[8];
#pragma unroll
        for (int z = 0; z < 8; ++z) {
            const unsigned p0 = 255u - (top[2 * z] & 0xffu), p1 = 255u - (top[2 * z + 1] & 0xffu);
            const unsigned i0 = (unsigned)myl[p0 >> 4] * 128u + (unsigned)myl[16 + (p0 & 15u)], i1 = (unsigned)myl[p1 >> 4] * 128u + (unsigned)myl[16 + (p1 & 15u)];
            idw[z] = i0 | (i1 << 16);
        }
        *((v4u*)IDS) = (v4u){idw[0], idw[1], idw[2], idw[3]}; *((v4u*)IDS + 1) = (v4u){idw[4], idw[5], idw[6], idw[7]};
#pragma unroll
        for (int q = 0; q < 4; ++q) {
            f32x4 gv; gv[0] = sv[4 * q] * inv; gv[1] = sv[4 * q + 1] * inv; gv[2] = sv[4 * q + 2] * inv; gv[3] = sv[4 * q + 3] * inv;
            *((f32x4*)GT + q) = gv;
        }
        asm volatile("s_waitcnt lgkmcnt(0)" ::: "memory");
    }
}

struct Grp { int grp, gidx, gsize; };
__device__ __forceinline__ Grp peer_group(int vcu, int G) { Grp g; if (G % 8 == 0) { g.grp = vcu / (G / 8); g.gidx = vcu % (G / 8); g.gsize = G / 8; } else { g.grp = vcu % 8; g.gidx = vcu / 8; g.gsize = (G - g.grp + 7) / 8; } return g; }
__device__ __forceinline__ void p8_ids(const unsigned char* ws, int t, unsigned ug, int (&ids)[16]) {
    const int tc = t < T ? t : T - 1; const v4u* IDS = (const v4u*)((const unsigned short*)(ws + WS_IDS) + (size_t)tc * 128) + 2u * ug;
#pragma unroll
    for (int q = 0; q < 2; ++q) { const v4u v = IDS[q];
        ids[8 * q] = (int)(v.x & 0xffffu); ids[8 * q + 1] = (int)(v.x >> 16); ids[8 * q + 2] = (int)(v.y & 0xffffu); ids[8 * q + 3] = (int)(v.y >> 16);
        ids[8 * q + 4] = (int)(v.z & 0xffffu); ids[8 * q + 5] = (int)(v.z >> 16); ids[8 * q + 6] = (int)(v.w & 0xffffu); ids[8 * q + 7] = (int)(v.w >> 16); }
}
__device__ __forceinline__ void p8_rows(const unsigned char* tab, unsigned toff, const int (&ids)[16], v4u (&rr)[16]) {
#pragma unroll
    for (int i = 0; i < 16; ++i) rr[i] = *(const v4u*)(tab + ((unsigned)ids[i] * 128u + toff));
}
__device__ __forceinline__ void p8a_hx(const float* H, int t, int col0, f32x4 (&hx)[4]) {
    const int tc = t < T ? t : T - 1;
#pragma unroll
    for (int q = 0; q < 4; ++q) hx[q] = *(const f32x4*)(H + (size_t)tc * DM + col0 + 4 * q);
}
__device__ __forceinline__ void p8a_down(const Ptrs& P, int vcu, int G) {
    FRESH_TID();
    unsigned char* ws = P.ws;
    const Grp gr = peer_group(vcu, G);
    const int slice = gr.grp >> 1, par = gr.grp & 1;
    const int g = lane >> 3, kq = lane & 7, col0 = slice * 256 + kq * 32;
    const unsigned char* tab = ws + WS_DOWN8 + (size_t)slice * PEER_E * 128;
    const unsigned toff = (unsigned)kq * 16u, ug = (unsigned)g;
    bf16* PART = (bf16*)(ws + WS_PART) + (size_t)slice * T * 128;
    const int tstep = 2 * gr.gsize * NWAVES; int t = par + 2 * (gr.gidx * NWAVES + wave);
    if (t >= T) return;
    const int ib = 8 * (kq & 1) + 4 * ((kq >> 1) & 1) + 2 * ((kq >> 2) & 1);
    const unsigned char* XQ = ws + WS_XQ; const float* XS = (const float*)(ws + WS_XS);
    int idn[16]; v4u rr[16]; v4u xa, xb, xan, xbn; float xdq, xdqn;
    const unsigned xoffb = (unsigned)slice * 128u + (unsigned)kq * 16u;
    p8_ids(ws, t, ug, idn); p8_rows(tab, toff, idn, rr);
    { const unsigned char* xp = XQ + (size_t)t * DM + xoffb; xa = *(const v4u*)xp; xb = *(const v4u*)(xp + 512); xdq = XS[(size_t)t * 4 + slice]; }
    p8_ids(ws, t + tstep, ug, idn);
    for (; t < T; t += tstep) {
        { const int tn = t + tstep, tc = tn < T ? tn : T - 1; const unsigned char* xp = XQ + (size_t)tc * DM + xoffb; xan = *(const v4u*)xp; xbn = *(const v4u*)(xp + 512); xdqn = XS[(size_t)tc * 4 + slice]; }
        int id2[16]; p8_ids(ws, t + 2 * tstep, ug, id2);
        const int xh[4] = {(int)xa.x, (int)xa.y, (int)xa.z, (int)xa.w}, xl[4] = {(int)xb.x, (int)xb.y, (int)xb.z, (int)xb.w};
        int res[16];
#pragma unroll
        for (int i = 0; i < 16; ++i) {
            const int w0 = (int)rr[i].x, w1 = (int)rr[i].y, w2 = (int)rr[i].z, w3 = (int)rr[i].w;
            int ah = __builtin_amdgcn_sdot8(w0, xh[0], 0, false); ah = __builtin_amdgcn_sdot8(w1, xh[1], ah, false); ah = __builtin_amdgcn_sdot8(w2, xh[2], ah, false); ah = __builtin_amdgcn_sdot8(w3, xh[3], ah, false);
            int al = __builtin_amdgcn_sdot8(w0, xl[0], 0, false); al = __builtin_amdgcn_sdot8(w1, xl[1], al, false); al = __builtin_amdgcn_sdot8(w2, xl[2], al, false); al = __builtin_amdgcn_sdot8(w3, xl[3], al, false);
            res[i] = 16 * ah + al;
            rr[i] = *(const v4u*)(tab + ((unsigned)idn[i] * 128u + toff));
            idn[i] = id2[i];
            asm volatile("" : "+v"(res[i]) :: "memory");
            __builtin_amdgcn_sched_barrier(0);
        }
        int q8[8], q4[4], q2[2];
        { const bool bt = lane & 1;
#pragma unroll
          for (int i = 0; i < 8; ++i) { const int send = bt ? res[i] : res[i + 8], keep = bt ? res[i + 8] : res[i]; q8[i] = keep + dpp_xor1i(send); } }
        { const bool bt = lane & 2;
#pragma unroll
          for (int i = 0; i < 4; ++i) { const int send = bt ? q8[i] : q8[i + 4], keep = bt ? q8[i + 4] : q8[i]; q4[i] = keep + dpp_xor2i(send); } }
        { const bool bt = lane & 4;
#pragma unroll
          for (int i = 0; i < 2; ++i) { const int send = bt ? q4[i] : q4[i + 2], keep = bt ? q4[i + 2] : q4[i]; q2[i] = keep + swz_xor4i(send); } }
        *(unsigned*)(PART + (size_t)t * 128 + 16 * g + ib) = pk2((float)q2[0] * xdq, (float)q2[1] * xdq);
        xa = xan; xb = xbn; xdq = xdqn;
    }
}
__device__ __forceinline__ void p8b_act(const Ptrs& P, int vcu, int G) {
    FRESH_TID();
    const int gw = vcu * NWAVES + wave, NGW = G * NWAVES;
    unsigned char* ws = P.ws;
    const bf16* PART = (const bf16*)(ws + WS_PART); const float* SD = (const float*)(ws + WS_SD); const float* SU = (const float*)(ws + WS_SU);
    for (int tb = gw; tb < T; tb += 4 * NGW) {
        float c[4][2], cm[4];
        int ids[4][2]; float av[4][2], gt[4][2], sq[4];
#pragma unroll
        for (int k = 0; k < 4; ++k) { const int t = tb + k * NGW < T ? tb + k * NGW : tb;
            sq[k] = lane < 16 ? ((const float*)(ws + WS_SSQ))[(size_t)t * 16 + lane] : 0.f;
#pragma unroll
            for (int hh = 0; hh < 2; ++hh) { const size_t i = (size_t)t * 128 + hh * 64 + lane; float a = 0.f;
#pragma unroll
                for (int sl = 0; sl < 4; ++sl) a += bf2f(PART[(size_t)sl * T * 128 + i]);
                av[k][hh] = a; ids[k][hh] = (int)((const unsigned short*)(ws + WS_IDS))[i]; gt[k][hh] = ((const float*)(ws + WS_GATES))[i]; } }
#pragma unroll
        for (int k = 0; k < 4; ++k) {
            const float r2 = 1.0f / sqrtf(wave_sum(sq[k]) * (1.0f / DM) + NORM_EPS);
#pragma unroll
            for (int hh = 0; hh < 2; ++hh) { const float a = av[k][hh] * SD[ids[k][hh]] * r2;
                const float act = 0.5f * a * (1.0f + erff(a * 0.7071067811865476f));
                c[k][hh] = gt[k][hh] * act * SU[ids[k][hh]]; }
            cm[k] = wave_max(fmaxf(fabsf(c[k][0]), fabsf(c[k][1])));
        }
#pragma unroll
        for (int k = 0; k < 4; ++k) { const int t = tb + k * NGW; if (t < T) {
            const float cs = cm[k] > 0.f ? 127.0f / cm[k] : 0.f;
            signed char* C8 = (signed char*)(ws + WS_C8) + (size_t)t * 128;
            C8[lane] = (signed char)(int)rintf(c[k][0] * cs); C8[64 + lane] = (signed char)(int)rintf(c[k][1] * cs);
            const int q0 = (int)rintf(c[k][0] * cs), q1 = (int)rintf(c[k][1] * cs);
            const float csum = wave_sum((float)(q0 + q1));
            if (lane == 0) { ((float*)(ws + WS_CSC))[t] = cm[k] * (1.0f / 127.0f); ((float*)(ws + WS_CSC))[T + t] = 8.0f * csum; } } }
    }
}
__device__ __forceinline__ void p8c_up(const Ptrs& P, int vcu, int G) {
    FRESH_TID();
    typedef int v4i __attribute__((ext_vector_type(4)));
    unsigned char* ws = P.ws;
    const Grp gr = peer_group(vcu, G);
    const int slice = gr.grp >> 1, par = gr.grp & 1;
    const int g = lane >> 3, cq = lane & 7, m = lane & 15, q = lane >> 4;
    const unsigned char* tab = ws + WS_UP8 + (size_t)slice * PEER_E * 128;
    const unsigned toff = (unsigned)cq * 16u, ug = (unsigned)g;
    const int sh = 8 * (m & 3);
    const int M0 = (m >> 2) == 0 ? -1 : 0, M1 = (m >> 2) == 1 ? -1 : 0, M2 = (m >> 2) == 2 ? -1 : 0, M3 = (m >> 2) == 3 ? -1 : 0;
    const int clo = slice * 256 + cq * 32 + ((q & 1) * 4 + (q >> 1) * 16), chi = clo + 8;
    const int tstep = 2 * gr.gsize * NWAVES; int t = par + 2 * (gr.gidx * NWAVES + wave);
    if (t >= T) return;
    int idn[16]; v4u rr[16]; v4u c0w, c1w;
    p8_ids(ws, t, ug, idn); p8_rows(tab, toff, idn, rr);
    { const v4u* C8 = (const v4u*)(ws + WS_C8 + (size_t)t * 128) + 2 * q; c0w = C8[0]; c1w = C8[1]; }
    p8_ids(ws, t + tstep, ug, idn);
    for (; t < T; t += tstep) {
        const int t1 = t + tstep;
        int id2[16]; p8_ids(ws, t + 2 * tstep, ug, id2);
        const v4u* C81 = (const v4u*)(ws + WS_C8 + (size_t)(t1 < T ? t1 : T - 1) * 128) + 2 * q; const v4u c0n = C81[0], c1n = C81[1];
        const unsigned cb0[4] = {c0w.x, c0w.y, c0w.z, c0w.w}, cb1[4] = {c1w.x, c1w.y, c1w.z, c1w.w};
        const float csc = ((const float*)(ws + WS_CSC))[t], cs8 = ((const float*)(ws + WS_CSC))[T + t];
        const bf16* hb = (const bf16*)(ws + WS_HB) + (size_t)t * DM;
        const v2u hwl = *(const v2u*)(hb + clo), hwh = *(const v2u*)(hb + chi);
        v4i aL0 = {0, 0, 0, 0}, aL1 = {0, 0, 0, 0}, aH0 = {0, 0, 0, 0}, aH1 = {0, 0, 0, 0};
#pragma unroll
        for (int i = 0; i < 16; ++i) {
            const int v0 = (int)(((cb0[i >> 2] >> (8 * (i & 3))) & 0xffu) << sh), v1 = (int)(((cb1[i >> 2] >> (8 * (i & 3))) & 0xffu) << sh);
            const v4i a0 = {v0 & M0, v0 & M1, v0 & M2, v0 & M3}, a1 = {v1 & M0, v1 & M1, v1 & M2, v1 & M3};
            const v4i bl = {(int)(rr[i].x & 0x0f0f0f0fu), (int)(rr[i].y & 0x0f0f0f0fu), (int)(rr[i].z & 0x0f0f0f0fu), (int)(rr[i].w & 0x0f0f0f0fu)};
            const v4i bh = {(int)((rr[i].x >> 4) & 0x0f0f0f0fu), (int)((rr[i].y >> 4) & 0x0f0f0f0fu), (int)((rr[i].z >> 4) & 0x0f0f0f0fu), (int)((rr[i].w >> 4) & 0x0f0f0f0fu)};
            aL0 = __builtin_amdgcn_mfma_i32_16x16x64_i8(a0, bl, aL0, 0, 0, 0); aL1 = __builtin_amdgcn_mfma_i32_16x16x64_i8(a1, bl, aL1, 0, 0, 0);
            aH0 = __builtin_amdgcn_mfma_i32_16x16x64_i8(a0, bh, aH0, 0, 0, 0); aH1 = __builtin_amdgcn_mfma_i32_16x16x64_i8(a1, bh, aH1, 0, 0, 0);
            rr[i] = *(const v4u*)(tab + ((unsigned)idn[i] * 128u + toff));
            idn[i] = id2[i];
            asm volatile("" : "+v"(aL0), "+v"(aL1), "+v"(aH0), "+v"(aH1) :: "memory");
            __builtin_amdgcn_sched_barrier(0);
        }
        c0w = c0n; c1w = c1n;
        int vl[4], vh[4];
#pragma unroll
        for (int r = 0; r < 4; ++r) { const int a = (m < 8) ? aL0[r] : aL1[r]; vl[r] = a + dpp_ror8i(a); const int b = (m < 8) ? aH0[r] : aH1[r]; vh[r] = b + dpp_ror8i(b); }
        if (m < 8) {
            f32x4 ol, oh;
            ol[0] = bflo(hwl.x) + ((float)vl[0] - cs8) * csc; ol[1] = bfhi(hwl.x) + ((float)vl[1] - cs8) * csc; ol[2] = bflo(hwl.y) + ((float)vl[2] - cs8) * csc; ol[3] = bfhi(hwl.y) + ((float)vl[3] - cs8) * csc;
            oh[0] = bflo(hwh.x) + ((float)vh[0] - cs8) * csc; oh[1] = bfhi(hwh.x) + ((float)vh[1] - cs8) * csc; oh[2] = bflo(hwh.y) + ((float)vh[2] - cs8) * csc; oh[3] = bfhi(hwh.y) + ((float)vh[3] - cs8) * csc;
            *(f32x4*)(P.out + (size_t)t * DM + clo) = ol; *(f32x4*)(P.out + (size_t)t * DM + chi) = oh;
        }
    }
}

#define XB_TMO      128
#define XB_XCNT(j)  (256  + 64 * (j))
#define XB_XSUB(j)  (1280 + 64 * (j))
#define XB_XGEN(j)  (2304 + 64 * (j))
#define XB_TOP      3328
#define XB_TOPGEN   3392
#define XCD_BAR_WORDS 3456
#define XB_SPIN_CAP (1u << 18)

__device__ __forceinline__ unsigned xb_ld(unsigned* p)              { return __hip_atomic_load(p, __ATOMIC_RELAXED, __HIP_MEMORY_SCOPE_AGENT); }
__device__ __forceinline__ unsigned xb_add(unsigned* p, unsigned v) { return __hip_atomic_fetch_add(p, v, __ATOMIC_RELAXED, __HIP_MEMORY_SCOPE_AGENT); }
__device__ __forceinline__ unsigned xb_xcc_id() { return (unsigned)__builtin_amdgcn_s_getreg((3 << 11) | 20) & 0xFu; }
#define XB_SPIN(cond, bar) do { unsigned _sp = 0; while (cond) { __builtin_amdgcn_s_sleep(1); \
    if ((++_sp & 255u) == 0u) { if (xb_ld(&(bar)[XB_TMO])) break; if (_sp > XB_SPIN_CAP) { atomicAdd(&(bar)[XB_TMO], 1u); break; } } } } while (0)

struct XcdBarrier {
    unsigned* bar; unsigned x;
    volatile LAS unsigned* st;
};

__device__ __forceinline__ XcdBarrier xcd_barrier_post(unsigned* bar, volatile LAS unsigned* st) {
    XcdBarrier b; b.bar = bar; b.x = xb_xcc_id(); b.st = st;
    if (threadIdx.x == 0) (void)xb_add(&bar[XB_XCNT(b.x)], 1u);
    return b;
}
__device__ __forceinline__ void xcd_barrier_complete(unsigned* bar, unsigned x, unsigned& nloc, unsigned& nx) {
    const unsigned G = gridDim.x * gridDim.y * gridDim.z;
    unsigned sum, cnt, mine, sp = 0u;
    for (;;) {
        sum = 0u; cnt = 0u; mine = 0u;
#pragma unroll
        for (unsigned j = 0; j < 16; ++j) { const unsigned c = xb_ld(&bar[XB_XCNT(j)]); sum += c; cnt += (c > 0u) ? 1u : 0u; mine = (j == x) ? c : mine; }
        if (sum == G) break;
        __builtin_amdgcn_s_sleep(1);
        if ((++sp & 255u) == 0u) { if (xb_ld(&bar[XB_TMO])) break; if (sp > XB_SPIN_CAP) { atomicAdd(&bar[XB_TMO], 1u); break; } }
    }
    nloc = mine > 0u ? mine : 1u; nx = cnt > 0u ? cnt : 1u;
}

__device__ __forceinline__ void xcd_barrier(const XcdBarrier& b) {
    asm volatile("s_waitcnt vmcnt(0)" ::: "memory");
    __syncthreads();
    if (threadIdx.x == 0) {
        unsigned* bar = b.bar;
        __builtin_amdgcn_s_waitcnt(0);
        unsigned nloc = b.st[0], nx = b.st[1];
        if (nloc == 0u) { xcd_barrier_complete(bar, b.x, nloc, nx); b.st[0] = nloc; b.st[1] = nx; }
        const unsigned old = xb_add(&bar[XB_XSUB(b.x)], 1u);
        const unsigned gen = old / nloc;
        if (old + 1u == (gen + 1u) * nloc) {
            __builtin_amdgcn_fence(__ATOMIC_RELEASE, "agent");
            asm volatile("s_waitcnt vmcnt(0)" ::: "memory");
            const unsigned og = xb_add(&bar[XB_TOP], 1u);
            const unsigned tg = og / nx;
            if (og + 1u == (tg + 1u) * nx) xb_add(&bar[XB_TOPGEN], 1u);
            else XB_SPIN(xb_ld(&bar[XB_TOPGEN]) == tg, bar);
            __builtin_amdgcn_fence(__ATOMIC_ACQUIRE, "agent");
            xb_add(&bar[XB_XGEN(b.x)], 1u);
            asm volatile("s_waitcnt vmcnt(0)" ::: "memory");
        } else {
            XB_SPIN(xb_ld(&bar[XB_XGEN(b.x)]) == gen, bar);
            __builtin_amdgcn_fence(__ATOMIC_ACQUIRE, "agent");
            asm volatile("s_waitcnt vmcnt(0)" ::: "memory");
        }
    }
    __syncthreads();
}

__global__ void __launch_bounds__(NTHR, 2) hymba_fwd(Ptrs P) {
    extern __shared__ __attribute__((aligned(16))) unsigned char lds_raw[];
    LAS unsigned char* lds = (LAS unsigned char*)lds_raw;
    const int tid = threadIdx.x;
    const int G = gridDim.x, bx = blockIdx.x, vcu = (G % 8 == 0) ? (bx % 8) * (G / 8) + bx / 8 : bx;
    unsigned char* ws = P.ws;
    if (tid < 64) ((LAS unsigned*)(lds + LDSCTL_OFF))[tid] = 0u;
    __syncthreads();
    XcdBarrier bar = xcd_barrier_post((unsigned*)(ws + WS_CTL) + CW_BAR, (volatile LAS unsigned*)(lds + LDSCTL_OFF));

    p0_wmax(P, vcu, G);
    __syncthreads();
    if (tid == 0) (void)__hip_atomic_fetch_add((unsigned*)(ws + WS_CTL) + CW_WCNT, 1u, __ATOMIC_RELEASE, __HIP_MEMORY_SCOPE_AGENT);
    p0_stream(P, lds, vcu, G);
    if (tid == 0) { XB_SPIN(xb_ld((unsigned*)(ws + WS_CTL) + CW_WCNT) < (unsigned)G, bar.bar); (void)__hip_atomic_load((unsigned*)(ws + WS_CTL) + CW_WCNT, __ATOMIC_ACQUIRE, __HIP_MEMORY_SCOPE_AGENT); }
    __syncthreads();
    p0_weights(P, lds, vcu, G);
    xcd_barrier(bar);

    {
        pg8::Gemm g{(const pg8::bf16_t*)(ws + WS_XA8), (const pg8::bf16_t*)(ws + WS_WIN), T, INW_MAIN, DM / 2}; pg8::StaticOrder S; S.init(T, INW_MAIN, G, bx);
        pg8::EpiProj E{(pg8::bf16_t*)(ws + WS_AQ), (pg8::bf16_t*)(ws + WS_AK), (pg8::bf16_t*)(ws + WS_AV), (pg8::bf16_t*)(ws + WS_MQ), (pg8::bf16_t*)(ws + WS_MK), (pg8::bf16_t*)(ws + WS_MV), (pg8::bf16_t*)(ws + WS_MO), (const float*)(ws + WS_SA), (const unsigned*)(ws + WS_CTL) + CW_WMAX};
        pg8::gemm_phase<pg8::EpiProj, pg8::StaticOrder, true, false, false, true>(lds, g, S, E);
    }
    xcd_barrier(bar);

    { for (int item = vcu; item < BATCH * MLH * NCHUNK; item += G) p2_mlstm_item(P, lds, item);
    p2_rows(P, vcu, G); p2_vt(P, vcu, G); }
    xcd_barrier(bar);

    p3_scan(P, lds, vcu, G);
    {
        const attn_body::AttnTensors AT{(const attn_body::bf16*)(ws + WS_AQ), (const unsigned char*)(ws + WS_AK8), (const unsigned char*)(ws + WS_AV8T), ws + WS_MIX, P.att_q_gain, P.att_k_gain};
        const attn_body::StaticOrder S(G, bx);
        __syncthreads();
        attn_body::attn_phase<attn_body::StaticOrder>((char*)lds_raw, AT, S);
    }
    xcd_barrier(bar);

    for (int item = vcu; item < BATCH * MLH * NCHUNK; item += G) p4_mlstm_item(P, lds, item);
    xcd_barrier(bar);

    {
        pg8::Gemm g{(const pg8::bf16_t*)(ws + WS_MIX), (const pg8::bf16_t*)(ws + WS_WOUT), T, DM, DM / 2}; pg8::StaticOrder S; S.init(T, DM, G, bx);
        pg8::EpiRes E{(const unsigned char*)(ws + WS_XA8), (const float*)(ws + WS_SA), (const float*)(ws + WS_RR), (pg8::bf16_t*)(ws + WS_HB), (float*)(ws + WS_SSQ), 1.0f / (W8SCALE * MIX8SCALE)};
        pg8::gemm_phase<pg8::EpiRes, pg8::StaticOrder, true, false, true>(lds, g, S, E);
    }
    xcd_barrier(bar);

    {
        pg8::Gemm g{(const pg8::bf16_t*)(ws + WS_HB), (const pg8::bf16_t*)(ws + WS_WEFF), T, 2048, DM}; pg8::StaticOrder S; S.init(T, 2048, G, bx);
        pg8::EpiScore E{(const float*)(ws + WS_SSQ), (unsigned short*)(ws + WS_SC), NORM_EPS};
        pg8::gemm_phase<pg8::EpiScore, pg8::StaticOrder, true, true>(lds, g, S, E);
    }
    xcd_barrier(bar);

    p7_topk(P, lds, vcu, G);
    xcd_barrier(bar);

    p8a_down(P, vcu, G);
    xcd_barrier(bar);
    p8b_act(P, vcu, G);
    xcd_barrier(bar);
    p8c_up(P, vcu, G);
}

extern "C" void kernel_launch(void* const* d_in, const int* in_sizes, int n_in, void* d_out, int out_size, void* d_ws, size_t ws_size, hipStream_t stream) {
    static int grid = 0;
    if (grid == 0) {
        if (n_in != 16 || in_sizes[0] != T * DM || out_size != T * DM || ws_size < WS_END) { fprintf(stderr, "kernel_launch: unexpected shapes (n_in %d, in0 %d, out %d, ws %zu); nothing launched\n", n_in, n_in > 0 ? in_sizes[0] : -1, out_size, ws_size); grid = -1; return; }
        int dev = 0, cus = 0, per_cu = 0;
        if (hipGetDevice(&dev) != hipSuccess || hipDeviceGetAttribute(&cus, hipDeviceAttributeMultiprocessorCount, dev) != hipSuccess) { grid = -1; return; }
        if (hipFuncSetAttribute((const void*)hymba_fwd, hipFuncAttributeMaxDynamicSharedMemorySize, LDS_BYTES) != hipSuccess) { fprintf(stderr, "kernel_launch: hipFuncSetAttribute failed\n"); grid = -1; return; }
        if (hipOccupancyMaxActiveBlocksPerMultiprocessor(&per_cu, (const void*)hymba_fwd, NTHR, LDS_BYTES) != hipSuccess || per_cu < 1) { fprintf(stderr, "kernel_launch: occupancy query reports %d workgroups per CU; nothing launched\n", per_cu); (void)hipGetLastError(); grid = -1; return; }
        grid = cus;
    }
    if (grid < 0) return;
    if (hipMemsetAsync((char*)d_ws + WS_CTL, 0, CTL_ZERO_BYTES, stream) != hipSuccess) return;
    Ptrs p{};
    p.x = (const float*)d_in[0]; p.norm1_gain = (const float*)d_in[1]; p.w_in = (const float*)d_in[2]; p.att_q_gain = (const float*)d_in[3]; p.att_k_gain = (const float*)d_in[4];
    p.ml_conv_w = (const float*)d_in[5]; p.ml_conv_b = (const float*)d_in[6]; p.ml_igate_bias = (const float*)d_in[7]; p.ml_fgate_bias = (const float*)d_in[8]; p.ml_out_gain = (const float*)d_in[9];
    p.w_out = (const float*)d_in[10]; p.norm2_gain = (const float*)d_in[11]; p.peer_w_query = (const float*)d_in[12]; p.peer_sub_keys = (const float*)d_in[13]; p.peer_down = (const float*)d_in[14]; p.peer_up = (const float*)d_in[15];
    p.out = (float*)d_out; p.ws = (unsigned char*)d_ws;
    hipLaunchKernelGGL(hymba_fwd, dim3(grid), dim3(NTHR), LDS_BYTES, stream, p);
}
```

```cpp
#include <hip/hip_runtime.h>
#include <cstdio>
#include <cstdint>
namespace pg8 {
#define PG8_LAS __attribute__((address_space(3)))
typedef unsigned short bf16_t;
typedef short bf16x8 __attribute__((ext_vector_type(8)));
typedef float f32x4 __attribute__((ext_vector_type(4)));
typedef unsigned u32x4 __attribute__((ext_vector_type(4)));
typedef int v8i32 __attribute__((ext_vector_type(8)));
constexpr int BM = 256, BK = 64, HALF = 128, HTB = HALF * BK * 2  , STAGE_BYTES = 8 * HTB, NXCD = 8, WGM = 8;

__host__ __device__ __forceinline__ int lds_byte(int r, int c) { const int st = (r >> 4) * 2 + (c >> 5), rr = r & 15, cc = c & 31, ob = rr * 64 + cc * 2; return st * 1024 + (ob ^ (((ob >> 9) & 1) << 5)); }
__host__ __device__ __forceinline__ void stage_rc(int b, int& R, int& C) { const int st = b / 1024, sb = b % 1024, swz = sb ^ (((sb >> 9) & 1) << 5); R = (st >> 1) * 16 + swz / 64; C = (st & 1) * 32 + (swz % 64) / 2; }
__host__ __device__ __forceinline__ int perm32(int rho) { const int n = rho >> 4, i = rho & 15; return 8 * (i >> 2) + 4 * n + (i & 3); }

struct Unit { int pm, pn; };
struct Gemm { const bf16_t* A; const bf16_t* Bt; int M, N, K; };

struct StaticOrder {
    int nM, nN, nwg, G, c;
    __host__ __device__ void init(int M, int N, int G_, int c_) { nM = M / BM; nN = N / BM; nwg = nM * nN; G = G_; c = c_; }
    __host__ __device__ bool next(int i, Unit& u) const {
        const long L = (long)i * G + c; if (L >= nwg) return false;
        int wgid = (int)L; { const int q = nwg / NXCD, r = nwg % NXCD, xcd = wgid % NXCD, off = wgid / NXCD; wgid = (xcd < r ? xcd * (q + 1) : r * (q + 1) + (xcd - r) * q) + off; }
        const int nig = WGM * nN, gid = wgid / nig, fm = gid * WGM, gsz = (nM - fm) < WGM ? (nM - fm) : WGM;
        u.pm = fm + ((wgid % nig) % gsz); u.pn = (wgid % nig) / gsz; return true;
    }
    __device__ __forceinline__ void a_ready(const Unit&) const {}
    __device__ __forceinline__ void done(const Unit&) const {}
};


__device__ __forceinline__ unsigned cvt_pk_bf16(float lo, float hi) { unsigned r; asm volatile("v_cvt_pk_bf16_f32 %0, %1, %2" : "=v"(r) : "v"(lo), "v"(hi)); return r; }
typedef float f32x2 __attribute__((ext_vector_type(2)));

struct EpiProj {
    static constexpr bool PERM = true, AFTER_DRAIN = false;
    bf16_t *AQ, *AK, *AV, *MQ, *MK, *MV, *MO; const float* SA; float sw; int pn0;
    __device__ __forceinline__ void operator()(const f32x4 (&acc)[2][2][4][2], const Unit& u, int wr, int wc, int fr, int fq) const {
        const int row0 = u.pm * BM + wr * 64 + fr;
        float rsc[2][4];
#pragma unroll
        for (int ai = 0; ai < 2; ++ai)
#pragma unroll
            for (int m = 0; m < 4; ++m) rsc[ai][m] = SA[row0 + ai * HALF + m * 16] * sw;
#pragma unroll
        for (int bj = 0; bj < 2; ++bj) {
            const int colt = (u.pn + pn0) * BM + bj * HALF;
            bf16_t* base; int ld, c0;
            if (colt < 512)       { base = AQ; ld = 512; c0 = colt; }
            else if (colt < 640)  { base = AK; ld = 128; c0 = colt - 512; }
            else if (colt < 768)  { base = AV; ld = 128; c0 = colt - 640; }
            else if (colt < 1280) { base = MQ; ld = 512; c0 = colt - 768; }
            else if (colt < 1792) { base = MK; ld = 512; c0 = colt - 1280; }
            else if (colt < 2304) { base = MV; ld = 512; c0 = colt - 1792; }
            else                  { base = MO; ld = 512; c0 = colt - 2304; }
            const int col0 = c0 + wc * 32 + 8 * fq;
#pragma unroll
            for (int ai = 0; ai < 2; ++ai)
#pragma unroll
                for (int m = 0; m < 4; ++m) {
                    const f32x4 v0 = acc[ai][bj][m][0] * rsc[ai][m], v1 = acc[ai][bj][m][1] * rsc[ai][m];
                    u32x4 w; w.x = cvt_pk_bf16(v0[0], v0[1]); w.y = cvt_pk_bf16(v0[2], v0[3]); w.z = cvt_pk_bf16(v1[0], v1[1]); w.w = cvt_pk_bf16(v1[2], v1[3]);
                    *(u32x4*)(base + (size_t)(row0 + ai * HALF + m * 16) * ld + col0) = w;
                }
        }
    }
};

struct EpiRes {
    static constexpr bool PERM = true, AFTER_DRAIN = false;
    const unsigned char* XA8; const float* SA; const float* RR; bf16_t* HB; float* SSQ; float sc;
    __device__ __forceinline__ void operator()(const f32x4 (&acc)[2][2][4][2], const Unit& u, int wr, int wc, int fr, int fq) const {
        const int col0 = u.pn * BM + wc * 32 + 8 * fq;
        typedef unsigned u32x2v __attribute__((ext_vector_type(2)));
#pragma unroll
        for (int ai = 0; ai < 2; ++ai) {
            u32x2v xw[4][2]; float rrv[4];
#pragma unroll
            for (int m = 0; m < 4; ++m) { const int row = u.pm * BM + ai * HALF + wr * 64 + m * 16 + fr; const size_t off = (size_t)row * 1024 + col0; rrv[m] = RR[row] * SA[row];
#pragma unroll
                for (int bj = 0; bj < 2; ++bj) xw[m][bj] = __builtin_nontemporal_load((const u32x2v*)(XA8 + off + bj * HALF)); }
#pragma unroll
            for (int m = 0; m < 4; ++m) {
                const int row = u.pm * BM + ai * HALF + wr * 64 + m * 16 + fr;
                const size_t off = (size_t)row * 1024 + col0;
                float ss = 0.f;
#pragma unroll
                for (int bj = 0; bj < 2; ++bj) {
                    unsigned wq[4];
#pragma unroll
                    for (int n = 0; n < 2; ++n) {
                        const int xq = (int)(n ? xw[m][bj].y : xw[m][bj].x);
                        const f32x4 xv = {(float)((xq << 24) >> 24), (float)((xq << 16) >> 24), (float)((xq << 8) >> 24), (float)(xq >> 24)};
                        const f32x4 hv = xv * rrv[m] + acc[ai][bj][m][n] * sc;
                        wq[2 * n] = cvt_pk_bf16(hv[0], hv[1]); wq[2 * n + 1] = cvt_pk_bf16(hv[2], hv[3]);
                        ss += (hv[0] * hv[0] + hv[1] * hv[1]) + (hv[2] * hv[2] + hv[3] * hv[3]);
                    }
                    u32x4 w; w.x = wq[0]; w.y = wq[1]; w.z = wq[2]; w.w = wq[3];
                    *(u32x4*)(HB + off + bj * HALF) = w;
                }
                ss += __shfl_xor(ss, 16); ss += __shfl_xor(ss, 32);
                if (fq == 0) SSQ[(size_t)row * 16 + u.pn * 4 + wc] = ss;
            }
        }
    }
};

struct EpiScore {
    static constexpr bool PERM = true, AFTER_DRAIN = false;
    const float* SSQ; unsigned short* SC; float eps;
    __device__ __forceinline__ void operator()(const f32x4 (&acc)[2][2][4][2], const Unit& u, int wr, int wc, int fr, int fq) const {
        const int row0 = u.pm * BM + wr * 64 + fr;
#pragma unroll
        for (int ai = 0; ai < 2; ++ai)
#pragma unroll
            for (int m = 0; m < 4; ++m) {
                const int row = row0 + ai * HALF + m * 16;
#pragma unroll
                for (int bj = 0; bj < 2; ++bj) {
                    const f32x4 v0 = acc[ai][bj][m][0], v1 = acc[ai][bj][m][1];
                    typedef _Float16 h2 __attribute__((ext_vector_type(2)));
                    u32x4 w;
                    { h2 t = {(_Float16)v0[0], (_Float16)v0[1]}; w.x = __builtin_bit_cast(unsigned, t); }
                    { h2 t = {(_Float16)v0[2], (_Float16)v0[3]}; w.y = __builtin_bit_cast(unsigned, t); }
                    { h2 t = {(_Float16)v1[0], (_Float16)v1[1]}; w.z = __builtin_bit_cast(unsigned, t); }
                    { h2 t = {(_Float16)v1[2], (_Float16)v1[3]}; w.w = __builtin_bit_cast(unsigned, t); }
                    w.x ^= (((w.x >> 15) & 0x00010001u) * 0x7fffu) | 0x80008000u; w.y ^= (((w.y >> 15) & 0x00010001u) * 0x7fffu) | 0x80008000u;
                    w.z ^= (((w.z >> 15) & 0x00010001u) * 0x7fffu) | 0x80008000u; w.w ^= (((w.w >> 15) & 0x00010001u) * 0x7fffu) | 0x80008000u;
                    *(u32x4*)(SC + ((((size_t)(row >> 6) * 16 + (u.pn * 2 + bj)) * 16 + (wc * 4 + fq)) * 64 + (row & 63)) * 8) = w;
                }
            }
    }
};

template <class Epi, class Sched, bool ALIGN_EPI = false, bool SP2 = false, bool F8 = false, bool I8 = false>
__device__ __forceinline__ void gemm_phase(PG8_LAS unsigned char* lds, const Gemm g, const Sched& S, const Epi& E) {
    int tid_ = threadIdx.x; asm volatile("" : "+v"(tid_));
    const int tid = tid_, wid = __builtin_amdgcn_readfirstlane(tid >> 6), lane = tid & 63, wr = wid >> 2, wc = wid & 3, fr = lane & 15, fq = lane >> 4;
    const int K = g.K, nt = K / BK;
    unsigned voffA[2], voffB[2];
#pragma unroll
    for (int i = 0; i < 2; ++i) { int R, C; stage_rc(tid * 16 + i * 8192, R, C); const int Rb = Epi::PERM ? ((R & ~31) + perm32(R & 31)) : R;
        voffA[i] = (unsigned)(R * K + C) * 2u; voffB[i] = (unsigned)(Rb * K + C) * 2u; }
    const size_t kstep = (size_t)(BK * 2);
    const size_t hstep = (size_t)HALF * K * 2;
    const size_t tstep = 2 * hstep;
    const unsigned ldsw = (unsigned)wid * 1024u;
    const int aoff = lds_byte(wr * 64 + fr, fq * 8), boff = lds_byte(wc * 32 + fr, fq * 8);
#define PG8_SA(b, h) (((b) * 2 + (h)) * HTB)
#define PG8_SB(b, h) ((4 + (b) * 2 + (h)) * HTB)
#define PG8_STAGE(bufoff, gbase, voff) do { _Pragma("unroll") for (int _i = 0; _i < 2; ++_i) \
        __builtin_amdgcn_global_load_lds((const unsigned*)((const char*)(gbase) + (voff)[_i]), (PG8_LAS unsigned*)(lds + (bufoff) + ldsw + _i * 8192), 16, 0, 0); } while (0)
#define PG8_LD8(p) ({ const u32x4 lo_ = *(const PG8_LAS u32x4*)(p), hi_ = *(const PG8_LAS u32x4*)((p) + 1024); (v8i32){(int)lo_.x, (int)lo_.y, (int)lo_.z, (int)lo_.w, (int)hi_.x, (int)hi_.y, (int)hi_.z, (int)hi_.w}; })
#define PG8_LDA(dst, b, h) do { _Pragma("unroll") for (int m = 0; m < 4; ++m) { if constexpr (F8) dst##8[m] = PG8_LD8(lds + PG8_SA(b, h) + aoff + m * 2048); else { _Pragma("unroll") for (int k = 0; k < 2; ++k) dst[m][k] = *(const PG8_LAS bf16x8*)(lds + PG8_SA(b, h) + aoff + m * 2048 + k * 1024); } } } while (0)
#define PG8_LDB(dst, b, h) do { _Pragma("unroll") for (int n = 0; n < 2; ++n) { if constexpr (F8) dst##8[n] = PG8_LD8(lds + PG8_SB(b, h) + boff + n * 2048); else { _Pragma("unroll") for (int k = 0; k < 2; ++k) dst[n][k] = *(const PG8_LAS bf16x8*)(lds + PG8_SB(b, h) + boff + n * 2048 + k * 1024); } } } while (0)
#define PG8_MMA(ai, bj, At, Bt) do { __builtin_amdgcn_s_setprio(3); \
        if constexpr (I8) { _Pragma("unroll") for (int k = 0; k < 2; ++k) _Pragma("unroll") for (int m = 0; m < 4; ++m) _Pragma("unroll") for (int n = 0; n < 2; ++n)   \
            asm volatile("v_mfma_i32_16x16x64_i8 %0, %1, %2, %0" : "+v"(acc[ai][bj][m][n]) : "v"(Bt[n][k]), "v"(At[m][k])); } \
        else { _Pragma("unroll") for (int m = 0; m < 4; ++m) _Pragma("unroll") for (int n = 0; n < 2; ++n) { \
        if constexpr (F8) asm volatile("v_mfma_f32_16x16x128_f8f6f4 %0, %1, %2, %0" : "+v"(acc[ai][bj][m][n]) : "v"(Bt##8[n]), "v"(At##8[m]));   \
        else { _Pragma("unroll") for (int k = 0; k < 2; ++k) acc[ai][bj][m][n] = __builtin_amdgcn_mfma_f32_16x16x32_bf16(Bt[n][k], At[m][k], acc[ai][bj][m][n], 0, 0, 0); } } } __builtin_amdgcn_s_setprio(0); } while (0)
#define PG8_WAIT_V(n) asm volatile("s_waitcnt vmcnt(" #n ")" ::: "memory")
#define PG8_WAIT_L(n) asm volatile("s_waitcnt lgkmcnt(" #n ")" ::: "memory")
#define PG8_BAR __builtin_amdgcn_s_barrier()
#define PG8_SCHED __builtin_amdgcn_sched_barrier(0)
    Unit cur, nxt; int ui = 0;
    if (!S.next(0, cur)) return;
    f32x4 acc[2][2][4][2];
#pragma unroll
    for (int a = 0; a < 2; ++a)
#pragma unroll
        for (int b = 0; b < 2; ++b)
#pragma unroll
            for (int m = 0; m < 4; ++m)
#pragma unroll
                for (int n = 0; n < 2; ++n) acc[a][b][m][n] = (f32x4){0.f, 0.f, 0.f, 0.f};
    bf16x8 At[4][2], B0[2][2], B1[2][2]; v8i32 At8[4], B08[2], B18[2];
    const char* cA = (const char*)g.A + (size_t)cur.pm * tstep; const char* cB = (const char*)g.Bt + (size_t)cur.pn * tstep;
    S.a_ready(cur);
    if constexpr (SP2) {
        PG8_STAGE(PG8_SB(0, 0), cB, voffB); PG8_STAGE(PG8_SB(0, 1), cB + hstep, voffB); PG8_STAGE(PG8_SA(0, 0), cA, voffA); PG8_STAGE(PG8_SA(0, 1), cA + hstep, voffA);
        if (wr == 1) PG8_BAR;
        PG8_WAIT_V(2); PG8_BAR;
        PG8_STAGE(PG8_SB(1, 0), cB + kstep, voffB); PG8_STAGE(PG8_SA(1, 0), cA + kstep, voffA); PG8_STAGE(PG8_SB(1, 1), cB + hstep + kstep, voffB);
        PG8_WAIT_V(6); PG8_BAR;
    } else {
        PG8_STAGE(PG8_SB(0, 0), cB, voffB); PG8_STAGE(PG8_SA(0, 0), cA, voffA); PG8_STAGE(PG8_SB(0, 1), cB + hstep, voffB); PG8_STAGE(PG8_SA(0, 1), cA + hstep, voffA);
        if (wr == 1) PG8_BAR;
        PG8_WAIT_V(4); PG8_BAR;
        PG8_STAGE(PG8_SB(1, 0), cB + kstep, voffB); PG8_STAGE(PG8_SA(1, 0), cA + kstep, voffA); PG8_STAGE(PG8_SB(1, 1), cB + hstep + kstep, voffB);
        PG8_WAIT_V(6); PG8_BAR;
    }
    for (;;) {
        const bool has_next = S.next(ui + 1, nxt);
        const char* nA = has_next ? (const char*)g.A + (size_t)nxt.pm * tstep : cA; const char* nB = has_next ? (const char*)g.Bt + (size_t)nxt.pn * tstep : cB;
        for (int t = 0; t < nt; t += 2) {
            const bool last = (t == nt - 2);
            const char* a1 = cA + (size_t)(t + 1) * kstep;
            const char* a2 = last ? nA : cA + (size_t)(t + 2) * kstep; const char* b2 = last ? nB : cB + (size_t)(t + 2) * kstep;
            const char* a3 = a2 + kstep; const char* b3 = b2 + kstep;
            if (last && has_next) S.a_ready(nxt);
            if constexpr (SP2) {
            PG8_LDB(B0, 0, 0); PG8_LDB(B1, 0, 1); PG8_SCHED; PG8_LDA(At, 0, 0); PG8_STAGE(PG8_SA(1, 1), a1 + hstep, voffA);
            PG8_WAIT_V(8); PG8_WAIT_L(0); PG8_BAR; PG8_MMA(0, 0, At, B0); PG8_MMA(0, 1, At, B1); PG8_BAR; PG8_SCHED;
            PG8_LDA(At, 0, 1); PG8_STAGE(PG8_SB(0, 0), b2, voffB); PG8_STAGE(PG8_SB(0, 1), b2 + hstep, voffB); PG8_STAGE(PG8_SA(0, 0), a2, voffA);
            PG8_WAIT_V(8); PG8_WAIT_L(0); PG8_BAR; PG8_MMA(1, 0, At, B0); PG8_MMA(1, 1, At, B1); PG8_BAR; PG8_SCHED;
            PG8_LDB(B0, 1, 0); PG8_LDB(B1, 1, 1); PG8_SCHED; PG8_LDA(At, 1, 0); PG8_STAGE(PG8_SA(0, 1), a2 + hstep, voffA);
            PG8_WAIT_V(8); PG8_WAIT_L(0); PG8_BAR; PG8_MMA(0, 0, At, B0); PG8_MMA(0, 1, At, B1); PG8_BAR; PG8_SCHED;
            PG8_LDA(At, 1, 1); PG8_STAGE(PG8_SB(1, 0), b3, voffB); PG8_STAGE(PG8_SB(1, 1), b3 + hstep, voffB); PG8_STAGE(PG8_SA(1, 0), a3, voffA);
            PG8_WAIT_V(8); PG8_WAIT_L(0); PG8_BAR; PG8_MMA(1, 0, At, B0); PG8_MMA(1, 1, At, B1); PG8_BAR; PG8_SCHED;
            } else {
            PG8_LDB(B0, 0, 0); PG8_SCHED; PG8_LDA(At, 0, 0); PG8_STAGE(PG8_SA(1, 1), a1 + hstep, voffA);
            PG8_WAIT_L(8); PG8_BAR; PG8_WAIT_L(0); PG8_MMA(0, 0, At, B0); PG8_BAR; PG8_SCHED;
            PG8_LDB(B1, 0, 1); PG8_STAGE(PG8_SB(0, 0), b2, voffB);
            PG8_BAR; PG8_WAIT_L(0); PG8_MMA(0, 1, At, B1); PG8_BAR;
            PG8_LDA(At, 0, 1); PG8_STAGE(PG8_SA(0, 0), a2, voffA);
            PG8_BAR; PG8_WAIT_L(0); PG8_MMA(1, 0, At, B0); PG8_BAR; PG8_SCHED;
            PG8_STAGE(PG8_SB(0, 1), b2 + hstep, voffB);
            PG8_WAIT_V(6); PG8_BAR; PG8_MMA(1, 1, At, B1); PG8_BAR;
            PG8_LDB(B0, 1, 0); PG8_SCHED; PG8_LDA(At, 1, 0); PG8_STAGE(PG8_SA(0, 1), a2 + hstep, voffA);
            PG8_WAIT_L(8); PG8_BAR; PG8_WAIT_L(0); PG8_MMA(0, 0, At, B0); PG8_BAR; PG8_SCHED;
            PG8_LDB(B1, 1, 1); PG8_STAGE(PG8_SB(1, 0), b3, voffB);
            PG8_BAR; PG8_WAIT_L(0); PG8_MMA(0, 1, At, B1); PG8_BAR;
            PG8_LDA(At, 1, 1); PG8_STAGE(PG8_SA(1, 0), a3, voffA);
            PG8_BAR; PG8_WAIT_L(0); PG8_MMA(1, 0, At, B0); PG8_BAR; PG8_SCHED;
            PG8_STAGE(PG8_SB(1, 1), b3 + hstep, voffB);
            PG8_WAIT_V(6); PG8_BAR; PG8_MMA(1, 1, At, B1); PG8_BAR;
            }
        }
        if constexpr (ALIGN_EPI) { if (wr == 0) PG8_BAR; }
        if constexpr (F8 || I8) asm volatile("s_nop 15\n\ts_nop 7" ::: "memory");
        if constexpr (I8) {
#pragma unroll
            for (int a = 0; a < 2; ++a)
#pragma unroll
                for (int b = 0; b < 2; ++b)
#pragma unroll
                    for (int m = 0; m < 4; ++m)
#pragma unroll
                        for (int n = 0; n < 2; ++n)
#pragma unroll
                            for (int c = 0; c < 4; ++c) { const float t_ = acc[a][b][m][n][c]; acc[a][b][m][n][c] = (float)__float_as_int(t_); }
        }
        if constexpr (!Epi::AFTER_DRAIN) { E(acc, cur, wr, wc, fr, fq); S.done(cur); }
        if (!has_next) break;
#pragma unroll
        for (int a = 0; a < 2; ++a)
#pragma unroll
            for (int b = 0; b < 2; ++b)
#pragma unroll
                for (int m = 0; m < 4; ++m)
#pragma unroll
                    for (int n = 0; n < 2; ++n) acc[a][b][m][n] = (f32x4){0.f, 0.f, 0.f, 0.f};
        cur = nxt; cA = nA; cB = nB; ++ui;
        if constexpr (ALIGN_EPI) { if (wr == 1) PG8_BAR; }
    }
    PG8_WAIT_V(0);
    if constexpr (!ALIGN_EPI) { if (wr == 0) PG8_BAR; }
    PG8_BAR;
    if constexpr (Epi::AFTER_DRAIN) { E.fused(acc, cur, wr, wc, fr, fq, lds, wid, lane); S.done(cur); }
#undef PG8_SA
#undef PG8_SB
#undef PG8_STAGE
#undef PG8_LDA
#undef PG8_LDB
#undef PG8_MMA
#undef PG8_LD8
#undef PG8_WAIT_V
#undef PG8_WAIT_L
#undef PG8_BAR
#undef PG8_SCHED
}
}

#define PG8_SP2 true
#define PG8_ALIGN true
#include <hip/hip_bf16.h>
#include <cmath>
namespace attn_body {
using bf16=__hip_bfloat16;
using bf16x8=__attribute__((ext_vector_type(8)))short;
using s16x4=__attribute__((ext_vector_type(4)))short;
using f32x16=__attribute__((ext_vector_type(16)))float;
using u32x4=__attribute__((ext_vector_type(4)))unsigned;
constexpr int BATCH=4,NHEAD=8,SEQ=8192,D=64;
constexpr int QP=512,KP=128,OP=1024;
constexpr int NW=8,QBLK=32,QB=QBLK*NW,KVBLK=64,NQB=SEQ/QB;
constexpr int ATTN_UNIT_ROWS=QB;
__device__ __forceinline__ int crow(int r,int hi){return (r&3)+8*(r>>2)+4*hi;}
#define SBAR() __builtin_amdgcn_sched_barrier(0)
__device__ __forceinline__ void cmask(f32x16&p0,f32x16&p1,int jb,int qrel,int hi){
  const float NEG=-INFINITY; int kb=64*jb+4*hi;
  #pragma unroll
  for(int r=0;r<16;++r){int kv=kb+(r&3)+8*(r>>2); if(kv>qrel)p0[r]=NEG; if(kv+32>qrel)p1[r]=NEG;}
}

constexpr int NSLOT=3, NVSLOT=4, SLOTB=4096, KSLOTB=4096;
constexpr int LDS_K=0, LDS_V=NSLOT*KSLOTB, LDS_WS=NSLOT*KSLOTB+NVSLOT*SLOTB, LDS_OST=LDS_WS+NW*64*4, LDS_BYTES=LDS_OST+NW*4096;
constexpr float OSCALE=16.0f;
constexpr float C2=0.125f*1.4426950408889634f;
__device__ __forceinline__ void glds16(const void*gsrc,unsigned lds_dst){unsigned keep;
  asm volatile("s_mov_b32 %0, m0\n\ts_mov_b32 m0, %2\n\ts_nop 0\n\tglobal_load_lds_dwordx4 %1, off\n\ts_mov_b32 m0, %0":"=&s"(keep):"v"(gsrc),"s"(lds_dst):"memory");}
__device__ __forceinline__ float max3f(float a,float b,float c){float r;asm("v_max3_f32 %0, %1, %2, %3":"=v"(r):"v"(a),"v"(b),"v"(c));return r;}
__device__ __forceinline__ float max2f(float a,float b){float r;asm("v_max_f32_e32 %0, %1, %2":"=v"(r):"v"(a),"v"(b));return r;}
__device__ __forceinline__ float fadd_s(float a,float b){float r;asm("v_add_f32_e32 %0, %1, %2":"=v"(r):"v"(a),"v"(b));return r;}
__device__ __forceinline__ float fsub_s(float a,float b){float r;asm("v_sub_f32_e32 %0, %1, %2":"=v"(r):"v"(a),"v"(b));return r;}
typedef float f32x2_t __attribute__((ext_vector_type(2))); typedef __bf16 bf16x2_t __attribute__((ext_vector_type(2)));
__device__ __forceinline__ unsigned cvtpk_s(float lo,float hi){f32x2_t v={lo,hi};bf16x2_t b=__builtin_convertvector(v,bf16x2_t);return __builtin_bit_cast(unsigned,b);}
#define WAIT_BAR(N) asm volatile("s_waitcnt vmcnt(" #N ") lgkmcnt(0)\n\ts_barrier":::"memory")
#define WAIT_BAR2(NK,NV) do{ if(wid<4) WAIT_BAR(NK); else WAIT_BAR(NV); }while(0)

typedef int v8i_t __attribute__((ext_vector_type(8)));
#define MFMA8(a,b,c) __builtin_amdgcn_mfma_scale_f32_32x32x64_f8f6f4((a),(b),(c),0,0,0,0,0,0)
#define MFMA8P(a,b,c) __builtin_amdgcn_mfma_scale_f32_32x32x64_f8f6f4((a),(b),(c),1,0,0,0,0,0)
typedef __attribute__((address_space(3))) const char* lds_cptr;
typedef short v4i16_t __attribute__((ext_vector_type(4)));
__device__ __forceinline__ v8i_t kfrag(lds_cptr kp,int ka0,int ka1){
  const u32x4 lo=*(const __attribute__((address_space(3))) u32x4*)(kp+ka0), hi_=*(const __attribute__((address_space(3))) u32x4*)(kp+ka1);
  return (v8i_t){(int)lo.x,(int)lo.y,(int)lo.z,(int)lo.w,(int)hi_.x,(int)hi_.y,(int)hi_.z,(int)hi_.w}; }
__device__ __forceinline__ float rowmax(const f32x16&p0,const f32x16&p1){
  float a=max3f(p0[0],p0[1],p1[0]),b=max3f(p0[2],p0[3],p1[1]);a=max3f(a,p1[2],p1[3]);
  #pragma unroll
  for(int r=4;r<16;r+=4){a=max3f(a,p0[r],p0[r+1]);b=max3f(b,p0[r+2],p0[r+3]);a=max3f(a,p1[r],p1[r+1]);b=max3f(b,p1[r+2],p1[r+3]);}
  const float m=max2f(a,b);
  auto rr=__builtin_amdgcn_permlane32_swap(__float_as_uint(m),__float_as_uint(m),false,false);
  return max2f(__uint_as_float(rr[0]),__uint_as_float(rr[1]));
}
#ifndef ATTN_STORE16
#define ATTN_STORE16(p,v) __builtin_nontemporal_store((v),(u32x4*)(p))
#endif
template<int THRL> __device__ __forceinline__ void attn_unit(int b,int h,int qb,const bf16*Q,const unsigned char*__restrict__ K8,const unsigned char*__restrict__ V8T,unsigned char*O,const float*__restrict__ qgain,const bool SM,char*shm){
  int tid_=threadIdx.x; asm volatile("":"+v"(tid_));
  const int tid=tid_,lane=tid&63,r32=lane&31,hi=lane>>5; const int wid=__builtin_amdgcn_readfirstlane(tid>>6);
  const long rowbase=(long)b*SEQ; const int q0=qb*QB;
  const bf16*Qw=Q+(rowbase+q0+wid*QBLK)*QP+h*D;
  const unsigned lds0=(unsigned)(uintptr_t)shm;
  float*wsf=(float*)(shm+LDS_WS)+wid*64;
  const unsigned char*ksrc=K8+(rowbase+16*(wid&3)+(lane>>2))*128+(h>>2)*64+(((lane&3)^((lane>>4)&3))*16);
  const unsigned char*vsrc=V8T+((long)(b*2+(h>>2))*(SEQ/KVBLK))*4096+(16*(wid&3)+(lane>>2))*64+(((lane&3)^((lane>>4)&3))*16);
  const unsigned kdst=lds0+LDS_K+(wid&3)*1024, vdst=lds0+LDS_V+(wid&3)*1024;
  #define DMA_K(t,slot) do{ if(wid<4) glds16(ksrc+(long)(t)*KVBLK*128,(unsigned)__builtin_amdgcn_readfirstlane(kdst+(slot))); }while(0)
  #define DMA_V(t,slot) do{ if(wid>=4) glds16(vsrc+(long)(t)*4096,(unsigned)__builtin_amdgcn_readfirstlane(vdst+(slot))); }while(0)
  v8i_t kfA,kfB;
  const int ksw=(r32>>2)&3, ka0=r32*64+(((2*hi)^ksw)*16), ka1=r32*64+(((2*hi+1)^ksw)*16);
  const lds_cptr shm3=(lds_cptr)shm; const lds_cptr kp0=shm3+LDS_K; const lds_cptr vp0=shm3+LDS_V;
  constexpr int NT=SEQ/KVBLK;
  DMA_K(0,0);DMA_V(0,0);DMA_K(1,KSLOTB);
  v8i_t q8;
  {
    u32x4 qraw[4];
    #pragma unroll
    for(int c=0;c<4;++c)qraw[c]=__builtin_nontemporal_load(reinterpret_cast<const u32x4*>(&Qw[(long)r32*QP+hi*32+c*8]));
    float f[32]; float ss=0.f;
    #pragma unroll
    for(int c=0;c<4;++c){
      #pragma unroll
      for(int j=0;j<4;++j){ const unsigned w=qraw[c][j]; f[c*8+2*j]=__builtin_bit_cast(float,w<<16); f[c*8+2*j+1]=__builtin_bit_cast(float,w&0xffff0000u); ss+=f[c*8+2*j]*f[c*8+2*j]+f[c*8+2*j+1]*f[c*8+2*j+1]; } }
    { auto rr=__builtin_amdgcn_permlane32_swap(__float_as_uint(ss),__float_as_uint(ss),false,false); ss=__uint_as_float(rr[0])+__uint_as_float(rr[1]); }
    const float rsq=C2/sqrtf(ss*(1.0f/64.0f)+1e-6f);
    const int pos=q0+wid*QBLK+r32; const float paxis=hi?(float)(pos&63):(float)(pos>>6);
    #pragma unroll
    for(int pp=0;pp<8;++pp){
      float r_[4];
      #pragma unroll
      for(int e=0;e<2;++e){ const int p=2*pp+e;
        float rev=paxis*__builtin_amdgcn_exp2f(-(float)p*(13.287712379549449f/16.0f))*0.15915494309189535f; rev-=floorf(rev);
        const float sn=__builtin_amdgcn_sinf(rev), cs=__builtin_amdgcn_cosf(rev);
        const float a0=f[2*p]*rsq*qgain[hi*32+2*p], a1=f[2*p+1]*rsq*qgain[hi*32+2*p+1];
        r_[2*e]=a0*cs-a1*sn; r_[2*e+1]=a0*sn+a1*cs; }
      int w_=0; w_=__builtin_amdgcn_cvt_pk_fp8_f32(r_[0],r_[1],w_,false); w_=__builtin_amdgcn_cvt_pk_fp8_f32(r_[2],r_[3],w_,true); q8[pp]=w_;
    }
  }
  float mhat=0.f;f32x16 o[2];o[0]=f32x16{};o[1]=f32x16{};const f32x16 z16=f32x16{};
  f32x16 lt=f32x16{}; v8i_t ones8; { _Pragma("unroll") for(int i_=0;i_<8;++i_)ones8[i_]=0x38383838; } asm volatile("":"+v"(ones8));
  const int qrel=wid*QBLK+r32;
  #define CMASK(P0,P1,t) do{}while(0)
  bool resc=false;
  #define START(P0,P1) do{ resc=false; \
    if(!SM){ const float rm=rowmax(P0,P1); const float dl=rm-7.0f; mhat=fadd_s(mhat,dl); \
      _Pragma("unroll") for(int r=0;r<16;++r){P0[r]=fsub_s(P0[r],dl);P1[r]=fsub_s(P1[r],dl);} } \
    _Pragma("unroll") for(int r=0;r<16;++r)P0[r]=__builtin_amdgcn_exp2f(P0[r]); }while(0)
  #define RESC() do{ if(resc){ asm volatile("s_waitcnt lgkmcnt(0)":::"memory"); \
      _Pragma("unroll") for(int r=0;r<16;++r){ const float f_=wsf[crow(r,hi)]; o[0][r]*=f_; o[1][r]*=f_; lt[r]*=f_; } } }while(0)
  f32x16 pA0,pA1,pB0,pB1;
  int sl_cur=0,sl_next=KSLOTB;
  int vs_prev=0,vs_cur=0,vs_next=SLOTB,vs_nn=2*SLOTB;
  #define ROT() do{sl_cur=sl_next;sl_next=(sl_next==(NSLOT-1)*KSLOTB)?0:sl_next+KSLOTB; vs_prev=vs_cur;vs_cur=vs_next;vs_next=vs_nn;vs_nn=(vs_nn==(NVSLOT-1)*SLOTB)?0:vs_nn+SLOTB;}while(0)
  DMA_K(2,2*KSLOTB);DMA_V(1,SLOTB);
  WAIT_BAR(2);
  kfA=kfrag(kp0,ka0,ka1);kfB=kfrag(kp0+2048,ka0,ka1);
  pA0=MFMA8(kfA,q8,z16);pA1=MFMA8(kfB,q8,z16);asm volatile("s_nop 15\n\ts_nop 7":"+v"(pA0),"+v"(pA1));CMASK(pA0,pA1,0);
  START(pA0,pA1);
  _Pragma("unroll") for(int r=0;r<16;++r)pA1[r]=__builtin_amdgcn_exp2f(pA1[r]);
  WAIT_BAR(0);
  DMA_K(3,0);DMA_V(2,2*SLOTB);
  ROT();
  kfA=kfrag(kp0+sl_cur,ka0,ka1);kfB=kfrag(kp0+sl_cur+2048,ka0,ka1);
  WAIT_BAR(1);
  v8i_t vfA,vfB,p8; p8=v8i_t{};
  #define PIN(x) asm volatile("":"+v"(x))
  #define MX3(a,b,c) __builtin_fmaxf(__builtin_fmaxf((a),(b)),(c))
  #define GAPA(MF,W0,W1,W2,W3,PW) do{ MF; W0; W1; W2; W3; PIN(PW); SBAR(); }while(0)
  #define EX(v) __builtin_amdgcn_exp2f(v)
  #define GAPB(MF,X,B) do{ MF; X[B]=EX(X[B]); X[B+1]=EX(X[B+1]); X[B+2]=EX(X[B+2]); X[B+3]=EX(X[B+3]); PIN(X); SBAR(); }while(0)
  #define PK8(k,P,B) do{ p8[k]=__builtin_amdgcn_cvt_pk_bf8_f32(P[B],P[B+1],p8[k],false); }while(0)
  #define PK8H(k,P,B) do{ p8[k]=__builtin_amdgcn_cvt_pk_bf8_f32(P[B],P[B+1],p8[k],true); }while(0)
  #define KRD(G,j) do{ if(G){ if((j)==0) kfA=kfrag(kp0+sl_next,ka0,ka1); else kfB=kfrag(kp0+sl_next+2048,ka0,ka1); SBAR(); } }while(0)
  #define STEP(C0,C1,P0,P1,t,GK,GV,GL) do{ SBAR(); \
    const lds_cptr vp_=vp0+vs_prev; \
    vfA=kfrag(vp_,ka0,ka1); SBAR(); \
    GAPA(C0=MFMA8(kfA,q8,z16), PK8(0,P0,0), PK8H(0,P0,2), PK8(1,P0,4), PK8H(1,P0,6), p8); \
    vfB=kfrag(vp_+2048,ka0,ka1); SBAR(); \
    GAPA(C1=MFMA8(kfB,q8,z16), PK8(2,P0,8), PK8H(2,P0,10), PK8(3,P0,12),PK8H(3,P0,14), p8); \
    GAPA((void)0, PK8(4,P1,0), PK8H(4,P1,2), PK8(5,P1,4), PK8H(5,P1,6), p8); \
    GAPA((void)0, PK8(6,P1,8), PK8H(6,P1,10), PK8(7,P1,12),PK8H(7,P1,14), p8); \
    if(GK){DMA_K((t)+3,sl_cur);} if(GV){DMA_V((t)+2,vs_nn);} \
    CMASK(C0,C1,t); \
    if(!SM){ _Pragma("unroll") for(int r=0;r<16;++r){C0[r]-=mhat;C1[r]-=mhat;} \
      float a=MX3(C0[0],C0[1],C1[0]),b=MX3(C0[2],C0[3],C1[1]); a=MX3(a,C1[2],C1[3]); \
      _Pragma("unroll") for(int r=4;r<16;r+=4){a=MX3(a,C0[r],C0[r+1]);b=MX3(b,C0[r+2],C0[r+3]);a=MX3(a,C1[r],C1[r+1]);b=MX3(b,C1[r+2],C1[r+3]);} \
      float rm=__builtin_fmaxf(a,b); { auto rr=__builtin_amdgcn_permlane32_swap(__float_as_uint(rm),__float_as_uint(rm),false,false); rm=__builtin_fmaxf(__uint_as_float(rr[0]),__uint_as_float(rr[1])); } \
      resc=false; \
      if(__builtin_expect(__any(rm>(float)THRL),0)){ const float dl=__builtin_fmaxf(rm,0.f); mhat+=dl; \
        _Pragma("unroll") for(int r=0;r<16;++r){C0[r]-=dl;C1[r]-=dl;} \
        const float f=__builtin_amdgcn_exp2f(-dl); if(hi==0)wsf[r32]=f; resc=true; } } \
    SBAR(); \
    GAPB(o[0]=MFMA8P(p8,vfA,o[0]), C0,0); \
    GAPB(o[1]=MFMA8P(p8,vfB,o[1]), C0,4); \
    KRD(GL,0); GAPB(lt=MFMA8P(p8,ones8,lt), C0,8); \
    GAPB((void)0, C0,12); \
    KRD(GL,1); GAPB((void)0, C1,0); \
    GAPB((void)0, C1,4); \
    GAPB((void)0, C1,8); \
    GAPB((void)0, C1,12); \
    }while(0)
  int t=1;
  #undef CMASK
  #define CMASK(P0,P1,t) do{}while(0)
  for(;t+5<NT;t+=2){
    STEP(pB0,pB1,pA0,pA1,t,true,true,true);     WAIT_BAR2(1,2); RESC(); ROT();
    STEP(pA0,pA1,pB0,pB1,t+1,true,true,true);   WAIT_BAR2(1,2); RESC(); ROT();
  }
  #undef CMASK
  #define CMASK(P0,P1,t) do{}while(0)
  #define ENDW(tt) do{ if((tt)+3<NT){WAIT_BAR2(1,2);} else if((tt)+3==NT){WAIT_BAR2(0,2);} else {WAIT_BAR(0);} }while(0)
  for(;t+1<NT;t+=2){
    STEP(pB0,pB1,pA0,pA1,t,(t+3<NT),(t+2<NT),(t+1<NT));       ENDW(t);   RESC(); ROT();
    STEP(pA0,pA1,pB0,pB1,t+1,(t+4<NT),(t+3<NT),(t+2<NT));     ENDW(t+1); RESC(); ROT();
  }
  STEP(pB0,pB1,pA0,pA1,NT-1,false,false,false); RESC();
  {
    PK8(0,pB0,0);PK8H(0,pB0,2);PK8(1,pB0,4);PK8H(1,pB0,6);PK8(2,pB0,8);PK8H(2,pB0,10);PK8(3,pB0,12);PK8H(3,pB0,14);PK8(4,pB1,0);PK8H(4,pB1,2);PK8(5,pB1,4);PK8H(5,pB1,6);PK8(6,pB1,8);PK8H(6,pB1,10);PK8(7,pB1,12);PK8H(7,pB1,14);
    SBAR(); vfA=kfrag(vp0+vs_cur,ka0,ka1); vfB=kfrag(vp0+vs_cur+2048,ka0,ka1); o[0]=MFMA8P(p8,vfA,o[0]); o[1]=MFMA8P(p8,vfB,o[1]); lt=MFMA8P(p8,ones8,lt); }
  #undef PK8
  #undef PK8H
  #undef PIN
  #undef MX3
  #undef GAPA
  #undef GAPB
  #undef EX
  #undef KRD
  #undef STEP
  #undef ENDW
  float rli[16];
  #pragma unroll
  for(int r=0;r<16;++r)rli[r]=__builtin_amdgcn_rcpf(lt[r]);
  unsigned char*Ow=O+(rowbase+q0+wid*QBLK)*OP+h*D;
  { unsigned char*stg=(unsigned char*)(shm+LDS_OST)+wid*2048;
    #pragma unroll
    for(int r=0;r<16;++r){const int orow=crow(r,hi);
      #pragma unroll
      for(int d0=0;d0<2;++d0){ int w8=0; w8=__builtin_amdgcn_cvt_pk_fp8_f32(fminf(fmaxf(o[d0][r]*rli[r]*OSCALE,-448.f),448.f),0.f,w8,false); stg[orow*64+d0*32+r32]=(unsigned char)(w8&0xff); } }
    asm volatile("s_waitcnt lgkmcnt(0)":::"memory");
    #pragma unroll
    for(int i=0;i<2;++i){const int row=i*16+(lane>>2),ch=lane&3; const u32x4 v=*(const u32x4*)(stg+row*64+ch*16); ATTN_STORE16(Ow+(long)row*OP+ch*16,v);} }
  asm volatile("s_waitcnt lgkmcnt(0)\n\ts_barrier":::"memory");
  #undef DMA_K
  #undef DMA_V
  #undef CMASK
  #undef START
  #undef RESC
  #undef ROT
}
constexpr int ATTN_LDS_BYTES=LDS_BYTES;
struct AttnTensors { const bf16* Q; const unsigned char* K8; const unsigned char* V8T; unsigned char* O; const float* qgain; const float* kgain; };
struct AttnUnit { int bh; int qb; };
struct StaticOrder {
  int vcu,G;
  __device__ __forceinline__ explicit StaticOrder(int grid,int block):vcu((grid%8==0)?(block%8)*(grid/8)+block/8:block),G(grid){}
  __device__ __forceinline__ bool next(int i,AttnUnit&u)const{ const int id=vcu+i*G; if(id>=BATCH*NHEAD*NQB)return false; const int grp=(id&255)>>5; u.bh=(grp>>1)*NHEAD+(grp&1)*4+(id>>8); u.qb=id&31; return true; }
  __device__ __forceinline__ void a_ready(const AttnUnit&)const{}
  __device__ __forceinline__ void done(const AttnUnit&)const{}
};
template<class Sched,int THRL=15> __device__ __forceinline__ void attn_phase(char*lds,const AttnTensors&T,const Sched&S){
  AttnUnit u;
  const int ln=threadIdx.x&63; float gq=fabsf(T.qgain[ln]),gk=fabsf(T.kgain[ln]);
  #pragma unroll
  for(int o_=32;o_>=1;o_>>=1){gq=fmaxf(gq,__shfl_xor(gq,o_));gk=fmaxf(gk,__shfl_xor(gk,o_));}
  const float bnd=64.0f*C2*1.02f*gq*gk;
#ifdef ATTN_FORCE_ONLINE
  const bool sm=false;
#else
  const bool sm=__builtin_amdgcn_readfirstlane(bnd<=15.5f?1:0)!=0;
#endif
  for(int i=0;S.next(i,u);++i){ S.a_ready(u); attn_unit<THRL>(u.bh/NHEAD,u.bh%NHEAD,u.qb,T.Q,T.K8,T.V8T,T.O,T.qgain,sm,lds); S.done(u); }
}
#undef SBAR
#undef WAIT_BAR
}

constexpr int NWAVES = 8, NTHR = NWAVES * 64;
constexpr int BATCH = 4, SEQ = 8192, DM = 1024, T = BATCH * SEQ;
constexpr int P1_COLS = 2560;
constexpr int INW = 2832, INW_MAIN = 2816;
constexpr float NORM_EPS = 1e-6f;
constexpr int MLH = 4, MLD = 128, NCHUNK = 64, CHL = 128;
constexpr int PEER_E = 16384;
constexpr size_t MiB = 1u << 20;
constexpr size_t WS_CTL = 0, CTL_ZERO_BYTES = 32768;
constexpr size_t WS_WIN = 2 * MiB, WS_WOUT = 8 * MiB, WS_WEFF = 10 * MiB;
constexpr size_t WS_SSQ = 14 * MiB, WS_LOGI = 16 * MiB, WS_LOGF = 17 * MiB, WS_SCAL = 18 * MiB, WS_MPREV = 18 * MiB + 65536, WS_DN = 19 * MiB;
constexpr size_t WS_DOWN8 = 32 * MiB, WS_UP8 = 48 * MiB, WS_SD = 20 * MiB, WS_SU = 20 * MiB + 65536, WS_MIX = 336 * MiB;
constexpr size_t WS_C8 = 21 * MiB, WS_CSC = 25 * MiB, WS_RR = 25 * MiB + 262144, WS_XS = 26 * MiB, WS_XQ = 128 * MiB;
constexpr size_t WS_PART = 96 * MiB;
constexpr size_t WS_AQ = 160 * MiB, WS_AK = 192 * MiB, WS_AV = 200 * MiB, WS_MQ = 208 * MiB, WS_MK = 240 * MiB, WS_MV = 272 * MiB, WS_MO = 304 * MiB;
constexpr size_t WS_CST = 400 * MiB;
constexpr size_t WS_XA8 = 368 * MiB, WS_SA = 25 * MiB + 524288;
constexpr float W8SCALE = 32.0f, MIX8SCALE = 16.0f;
constexpr size_t WS_AV8T = 26 * MiB;
constexpr size_t WS_AK8 = 21 * MiB;
constexpr size_t WS_HB = 160 * MiB, WS_SC = 224 * MiB, WS_IDS = 400 * MiB, WS_GATES = 416 * MiB, WS_END = 464 * MiB;

constexpr int CW_BAR = 4096, CW_WMAX = 16, CW_WCNT = 80;
constexpr int LDS_BYTES = 147456, LDSCTL_OFF = LDS_BYTES - 256;
constexpr int TPITCH = 136;
constexpr int TILE_B = 128 * TPITCH * 2;

#define GAS __attribute__((address_space(1)))
#define LAS __attribute__((address_space(3)))
typedef unsigned short bf16;
typedef unsigned v4u __attribute__((ext_vector_type(4)));
typedef unsigned v2u __attribute__((ext_vector_type(2)));
typedef float f32x4 __attribute__((ext_vector_type(4)));
typedef float f32x2 __attribute__((ext_vector_type(2)));
typedef short bf16x8 __attribute__((ext_vector_type(8)));
typedef __bf16 bf16x2v __attribute__((ext_vector_type(2)));
#define FRESH_TID() int tid = threadIdx.x; asm volatile("" : "+v"(tid)); const int lane = tid & 63; const int wave = __builtin_amdgcn_readfirstlane(tid >> 6); (void)lane; (void)wave
#define LDS_WAIT() asm volatile("s_waitcnt lgkmcnt(0)" ::: "memory")
#define VM_WAIT() asm volatile("s_waitcnt vmcnt(0)" ::: "memory")
typedef __bf16 bf16x2cv __attribute__((ext_vector_type(2)));
__device__ __forceinline__ unsigned pk2(float lo, float hi) { f32x2 v = {lo, hi}; return __builtin_bit_cast(unsigned, __builtin_convertvector(v, bf16x2cv)); }
__device__ __forceinline__ unsigned f2bf(float f) { return pk2(f, 0.f) & 0xffffu; }
__device__ __forceinline__ float bf2f(unsigned short b) { return __builtin_bit_cast(float, (unsigned)b << 16); }
__device__ __forceinline__ float bflo(unsigned u) { return __builtin_bit_cast(float, u << 16); }
__device__ __forceinline__ float bfhi(unsigned u) { return __builtin_bit_cast(float, u & 0xffff0000u); }
__device__ __forceinline__ float fexp(float x) { return __builtin_amdgcn_exp2f(x * 1.4426950408889634f); }
__device__ __forceinline__ float fsigmoid(float x) { return __builtin_amdgcn_rcpf(1.0f + fexp(-x)); }
__device__ __forceinline__ float dot2bf(unsigned a, unsigned b, float acc) { return __builtin_amdgcn_fdot2_f32_bf16(__builtin_bit_cast(bf16x2v, a), __builtin_bit_cast(bf16x2v, b), acc, false); }
template <int CTRL> __device__ __forceinline__ float dpp_f(float x) { return __builtin_bit_cast(float, __builtin_amdgcn_update_dpp(0, __builtin_bit_cast(int, x), CTRL, 0xF, 0xF, false)); }
__device__ __forceinline__ float swz4_f(float x) { return __builtin_bit_cast(float, __builtin_amdgcn_ds_swizzle(__builtin_bit_cast(int, x), 0x101F)); }
__device__ __forceinline__ float wave_sum(float v) {
    v += dpp_f<0xB1>(v); v += dpp_f<0x4E>(v); v += dpp_f<0x141>(v); v += dpp_f<0x128>(v);
    v += __shfl_xor(v, 16); v += __shfl_xor(v, 32);
    return v;
}
__device__ __forceinline__ float wave_max(float v) {
    v = fmaxf(v, dpp_f<0xB1>(v)); v = fmaxf(v, dpp_f<0x4E>(v)); v = fmaxf(v, dpp_f<0x141>(v)); v = fmaxf(v, dpp_f<0x128>(v));
    v = fmaxf(v, __shfl_xor(v, 16)); v = fmaxf(v, __shfl_xor(v, 32));
    return v;
}
__device__ __forceinline__ float wave_incl_add(float v, int lane) {
#pragma unroll
    for (int o = 1; o < 64; o <<= 1) { const float t = __shfl_up(v, o); if (lane >= o) v += t; }
    return v;
}
__device__ __forceinline__ float wave_incl_max(float v, int lane) {
#pragma unroll
    for (int o = 1; o < 64; o <<= 1) { const float t = __shfl_up(v, o); if (lane >= o) v = fmaxf(v, t); }
    return v;
}
__device__ __forceinline__ float wave_incl_max_rev(float v, int lane) {
#pragma unroll
    for (int o = 1; o < 64; o <<= 1) { const float t = __shfl_down(v, o); if (lane + o < 64) v = fmaxf(v, t); }
    return v;
}
__device__ __forceinline__ float reduce16(const float (&p)[16], int lane) {
    float q[8], r[4], s[2];
    { const bool b = lane & 1;
#pragma unroll
      for (int i = 0; i < 8; ++i) { const float send = b ? p[i] : p[i + 8], keep = b ? p[i + 8] : p[i]; q[i] = keep + dpp_f<0xB1>(send); } }
    { const bool b = lane & 2;
#pragma unroll
      for (int i = 0; i < 4; ++i) { const float send = b ? q[i] : q[i + 4], keep = b ? q[i + 4] : q[i]; r[i] = keep + dpp_f<0x4E>(send); } }
    { const bool b = lane & 4;
#pragma unroll
      for (int i = 0; i < 2; ++i) { const float send = b ? r[i] : r[i + 2], keep = b ? r[i + 2] : r[i]; s[i] = keep + swz4_f(send); } }
    float v;
    { const bool b = lane & 8; const float send = b ? s[0] : s[1], keep = b ? s[1] : s[0]; v = keep + dpp_f<0x128>(send); }
    v += __shfl_xor(v, 16); v += __shfl_xor(v, 32);
    return v;
}
__device__ __forceinline__ int bitrev4(int x) { return ((x & 1) << 3) | ((x & 2) << 1) | ((x & 4) >> 1) | ((x & 8) >> 3); }

template <int KD> __device__ __forceinline__ void wave_gemm(const LAS bf16* A, int arow0, const LAS bf16* Bt, f32x4 (&acc)[8], int lane) {
    const int fr = lane & 15, fq = lane >> 4;
#pragma unroll
    for (int ks = 0; ks < KD / 32; ++ks) {
        const bf16x8 a = *(const LAS bf16x8*)(A + (arow0 + fr) * TPITCH + ks * 32 + fq * 8);
#pragma unroll
        for (int nt = 0; nt < 8; ++nt) {
            const bf16x8 b = *(const LAS bf16x8*)(Bt + (nt * 16 + fr) * TPITCH + ks * 32 + fq * 8);
            acc[nt] = __builtin_amdgcn_mfma_f32_16x16x32_bf16(a, b, acc[nt], 0, 0, 0);
        }
    }
}

struct Ptrs {
    const float *x, *norm1_gain, *w_in, *att_q_gain, *att_k_gain, *ml_conv_w, *ml_conv_b, *ml_igate_bias, *ml_fgate_bias, *ml_out_gain, *w_out, *norm2_gain, *peer_w_query, *peer_sub_keys, *peer_down, *peer_up;
    float* out; unsigned char* ws;
};

__device__ __forceinline__ unsigned pk4_fp8(float a, float b, float c, float d) { int w = 0; w = __builtin_amdgcn_cvt_pk_fp8_f32(fminf(fmaxf(a, -448.f), 448.f), fminf(fmaxf(b, -448.f), 448.f), w, false);
    w = __builtin_amdgcn_cvt_pk_fp8_f32(fminf(fmaxf(c, -448.f), 448.f), fminf(fmaxf(d, -448.f), 448.f), w, true); return (unsigned)w; }
__device__ __forceinline__ unsigned pk4_i8(float a, float b, float c, float d) {
    const int ia = (int)fminf(fmaxf(rintf(a), -127.f), 127.f), ib = (int)fminf(fmaxf(rintf(b), -127.f), 127.f), ic = (int)fminf(fmaxf(rintf(c), -127.f), 127.f), id = (int)fminf(fmaxf(rintf(d), -127.f), 127.f);
    return (unsigned)(ia & 0xff) | ((unsigned)(ib & 0xff) << 8) | ((unsigned)(ic & 0xff) << 16) | ((unsigned)id << 24); }
template <int MODE> __device__ __forceinline__ void p0_transpose_item(const float* W, int ldw, const float* gain, unsigned char* WT, int K, LAS float* scr, int kb, int nb, int lane, float qs = 1.0f) {
    constexpr bool F8 = MODE == 1;
    const int k0 = 64 * kb, n0 = 32 * nb;
#pragma unroll 8
    for (int i = 0; i < 32; ++i) { const int kk = 2 * i + (lane >> 5); const float g = (gain ? gain[k0 + kk] : 1.0f) * (F8 ? W8SCALE : (MODE == 2 ? qs : 1.0f)); scr[kk * 33 + (lane & 31)] = W[(size_t)(k0 + kk) * ldw + n0 + (lane & 31)] * g; }
    LDS_WAIT(); asm volatile("" ::: "memory");
    const int c = lane & 7;
#pragma unroll
    for (int j = 0; j < 4; ++j) { const int n = (lane >> 3) + 8 * j; const LAS float* s = scr + (8 * c) * 33 + n;
        if constexpr (F8) { v2u o; o.x = pk4_fp8(s[0 * 33], s[1 * 33], s[2 * 33], s[3 * 33]); o.y = pk4_fp8(s[4 * 33], s[5 * 33], s[6 * 33], s[7 * 33]);
            *(GAS v2u*)(WT + (size_t)(n0 + n) * K + k0 + 8 * c) = o; }
        else if constexpr (MODE == 2) { v2u o; o.x = pk4_i8(s[0 * 33], s[1 * 33], s[2 * 33], s[3 * 33]); o.y = pk4_i8(s[4 * 33], s[5 * 33], s[6 * 33], s[7 * 33]);
            *(GAS v2u*)(WT + (size_t)(n0 + n) * K + k0 + 8 * c) = o; }
        else { v4u o; o.x = pk2(s[0 * 33], s[1 * 33]); o.y = pk2(s[2 * 33], s[3 * 33]); o.z = pk2(s[4 * 33], s[5 * 33]); o.w = pk2(s[6 * 33], s[7 * 33]);
            *(GAS v4u*)((bf16*)WT + (size_t)(n0 + n) * K + k0 + 8 * c) = o; } }
    LDS_WAIT(); asm volatile("" ::: "memory");
}

__device__ __forceinline__ void p0_wmax(const Ptrs& P, int vcu, int G) {
    FRESH_TID();
    float mx = 0.f;
    constexpr int NV = DM * (INW_MAIN / 4);
    for (int base = vcu * NTHR + tid; base < NV; base += 8 * G * NTHR) {
        f32x4 v[8]; float g[8];
#pragma unroll
        for (int u = 0; u < 8; ++u) { const int idx = base + u * G * NTHR, ic = idx < NV ? idx : base; const int k = ic / (INW_MAIN / 4), c4 = ic % (INW_MAIN / 4);
            v[u] = *(const f32x4*)(P.w_in + (size_t)k * INW + c4 * 4); g[u] = fabsf(P.norm1_gain[k]); }
#pragma unroll
        for (int u = 0; u < 8; ++u) mx = fmaxf(mx, g[u] * fmaxf(fmaxf(fabsf(v[u][0]), fabsf(v[u][1])), fmaxf(fabsf(v[u][2]), fabsf(v[u][3]))));
    }
    mx = wave_max(mx);
    if (lane == 0) atomicMax((unsigned*)(P.ws + WS_CTL) + CW_WMAX, __builtin_bit_cast(unsigned, mx));
}
__device__ __forceinline__ void p0_weights(const Ptrs& P, LAS unsigned char* lds, int vcu, int G) {
    FRESH_TID();
    const int gw = vcu * NWAVES + wave, NGW = G * NWAVES;
    unsigned char* ws = P.ws;
    {
        const float wmax_in = __builtin_bit_cast(float, __hip_atomic_load((unsigned*)(ws + WS_CTL) + CW_WMAX, __ATOMIC_RELAXED, __HIP_MEMORY_SCOPE_AGENT)); const float qs_in = wmax_in > 0.f ? 127.0f / wmax_in : 0.f;
        LAS float* scr = (LAS float*)(lds + wave * 8704);
        constexpr int I_IN = 16 * 88, I_OUT = 16 * 32;
        for (int it = gw; it < I_IN + I_OUT; it += NGW) {
            if (it < I_IN) p0_transpose_item<2>(P.w_in, INW, P.norm1_gain, ws + WS_WIN, DM, scr, it / 88, it % 88, lane, qs_in);
            else { const int r = it - I_IN; p0_transpose_item<1>(P.w_out, DM, nullptr, ws + WS_WOUT, DM, scr, r / 32, r % 32, lane); }
        }
    }
    __syncthreads();
    for (int item = vcu; item < 256; item += G) {
        const int g = item >> 4, k0 = (item & 15) * 64;
        LAS bf16* SKB = (LAS bf16*)lds; LAS bf16* WQB = (LAS bf16*)(lds + TILE_B);
#pragma unroll
        for (int i = 0; i < 4; ++i) { const int idx = tid + NTHR * i, r = idx >> 5, c4 = idx & 31;
            const f32x4 v = *(const f32x4*)(P.peer_w_query + (size_t)(k0 + r) * 2048 + g * 128 + c4 * 4) * P.norm2_gain[k0 + r];
            v2u w; w.x = pk2(v[0], v[1]); w.y = pk2(v[2], v[3]); *(LAS v2u*)(WQB + r * TPITCH + c4 * 4) = w; }
#pragma unroll
        for (int i = 0; i < 8; ++i) { const int idx = tid + NTHR * i, r = idx >> 5, c4 = idx & 31;
            const f32x4 v = *(const f32x4*)(P.peer_sub_keys + ((size_t)g * 128 + r) * 128 + c4 * 4);
            v2u w; w.x = pk2(v[0], v[1]); w.y = pk2(v[2], v[3]); *(LAS v2u*)(SKB + r * TPITCH + c4 * 4) = w; }
        __syncthreads();
        {
            const int fr = lane & 15, fq = lane >> 4;
            f32x4 acc[4];
#pragma unroll
            for (int nt = 0; nt < 4; ++nt) acc[nt] = (f32x4){0.f, 0.f, 0.f, 0.f};
#pragma unroll
            for (int ks = 0; ks < 4; ++ks) {
                const bf16x8 a = *(const LAS bf16x8*)(SKB + (wave * 16 + fr) * TPITCH + ks * 32 + fq * 8);
#pragma unroll
                for (int nt = 0; nt < 4; ++nt) { const bf16x8 b = *(const LAS bf16x8*)(WQB + (nt * 16 + fr) * TPITCH + ks * 32 + fq * 8); acc[nt] = __builtin_amdgcn_mfma_f32_16x16x32_bf16(a, b, acc[nt], 0, 0, 0); }
            }
            bf16* WE = (bf16*)(ws + WS_WEFF);
#pragma unroll
            for (int nt = 0; nt < 4; ++nt)
#pragma unroll
                for (int r = 0; r < 4; ++r) WE[(size_t)(g * 128 + wave * 16 + fq * 4 + r) * DM + k0 + nt * 16 + fr] = (bf16)f2bf(acc[nt][r]);
        }
        __syncthreads();
    }
}
__device__ __forceinline__ void p0_stream(const Ptrs& P, LAS unsigned char* lds, int vcu, int G) {
    FRESH_TID();
    const int gw = vcu * NWAVES + wave, NGW = G * NWAVES;
    unsigned char* ws = P.ws;
    {
    f32x4 nxt[4];
    { const int rc = gw < 2 * PEER_E ? gw : 0; const bool up = rc >= PEER_E; const int e = up ? rc - PEER_E : rc;
      const f32x4* src = (const f32x4*)((up ? P.peer_up : P.peer_down) + (size_t)e * DM) + lane; nxt[0] = src[0]; nxt[1] = src[64]; nxt[2] = src[128]; nxt[3] = src[192]; }
    for (int r = gw; r < 2 * PEER_E; r += NGW) {
        const bool up = r >= PEER_E; const int e = up ? r - PEER_E : r;
        f32x4 v[4] = {nxt[0], nxt[1], nxt[2], nxt[3]};
        { const int rn = r + NGW, rc = rn < 2 * PEER_E ? rn : r; const bool upn = rc >= PEER_E; const int en = upn ? rc - PEER_E : rc;
          const f32x4* src = (const f32x4*)((upn ? P.peer_up : P.peer_down) + (size_t)en * DM) + lane;
          nxt[0] = __builtin_nontemporal_load(src); nxt[1] = __builtin_nontemporal_load(src + 64); nxt[2] = __builtin_nontemporal_load(src + 128); nxt[3] = __builtin_nontemporal_load(src + 192); }
        if (!up) { const f32x4* gp = (const f32x4*)P.norm2_gain + lane; v[0] = v[0] * gp[0]; v[1] = v[1] * gp[64]; v[2] = v[2] * gp[128]; v[3] = v[3] * gp[192]; }
        float mx = 0.f;
#pragma unroll
        for (int q = 0; q < 4; ++q) mx = fmaxf(mx, fmaxf(fmaxf(fabsf(v[q][0]), fabsf(v[q][1])), fmaxf(fabsf(v[q][2]), fabsf(v[q][3]))));
        mx = wave_max(mx);
        {
            float ss = 0.f;
#pragma unroll
            for (int q = 0; q < 4; ++q) ss += (v[q][0] * v[q][0] + v[q][1] * v[q][1]) + (v[q][2] * v[q][2] + v[q][3] * v[q][3]);
            const float clip = fminf(mx, 2.5f * sqrtf(wave_sum(ss) * (1.0f / DM)));
            const float inv4 = clip > 0.f ? 7.0f / clip : 0.f;
#pragma unroll
            for (int j = 0; j < 4; ++j) {
                unsigned w = 0;
#pragma unroll
                for (int c = 0; c < 4; ++c) { const int qv = (int)fminf(fmaxf(rintf(v[j][c] * inv4), -7.0f), 7.0f); w |= ((up && !(lane & 2)) ? (unsigned)(qv + 8) : ((unsigned)qv & 0xfu)) << (8 * c); }
                const unsigned pw = (unsigned)__builtin_amdgcn_update_dpp(0, (int)w, 0x4E, 0xF, 0xF, false);
                if ((lane & 2) == 0) __builtin_nontemporal_store(w | (pw << 4), (GAS unsigned*)(ws + (up ? WS_UP8 : WS_DOWN8) + ((size_t)j * PEER_E + e) * 128 + (lane >> 2) * 8 + (lane & 1) * 4));
            }
            if (lane == 0) ((float*)(ws + (up ? WS_SU : WS_SD)))[e] = clip * (1.0f / 7.0f);
        }
    }
    }
    {
    __syncthreads();
    constexpr int GP = 1032;
    constexpr int XSP = 2080;
    LAS bf16* GWB = (LAS bf16*)lds;
    LAS unsigned char* XST = lds + 33280 + wave * (4 * XSP);
    for (int i = 0; i < 32; ++i) { const int idx = tid + NTHR * i, k = idx >> 4, j = idx & 15; GWB[j * GP + k] = (bf16)f2bf(P.w_in[(size_t)k * INW + INW_MAIN + j] * P.norm1_gain[k]); }
    __syncthreads();
    {
        f32x4 xn[4];
        { const f32x4* xr = (const f32x4*)(P.x + (size_t)(gw < T ? gw : 0) * DM) + lane;
#pragma unroll
          for (int j = 0; j < 4; ++j) xn[j] = __builtin_nontemporal_load(xr + 64 * j); }
        for (int mb = gw; mb < T; mb += 4 * NGW) {
#pragma unroll
        for (int ri = 0; ri < 4; ++ri) { const int m = mb + ri * NGW; if (m < T) {
            f32x4 v[4]; float ss = 0.f;
#pragma unroll
            for (int j = 0; j < 4; ++j) { v[j] = xn[j]; ss += (v[j][0] * v[j][0] + v[j][1] * v[j][1]) + (v[j][2] * v[j][2] + v[j][3] * v[j][3]); }
            { const int mn = m + NGW; const f32x4* xr = (const f32x4*)(P.x + (size_t)(mn < T ? mn : m) * DM) + lane;
#pragma unroll
              for (int j = 0; j < 4; ++j) xn[j] = __builtin_nontemporal_load(xr + 64 * j); }
            const float rr1 = sqrtf(wave_sum(ss) * (1.0f / DM) + NORM_EPS), r1 = 1.0f / rr1;
            if (lane == 0) ((float*)(ws + WS_RR))[m] = rr1;
#pragma unroll
            for (int j = 0; j < 4; ++j) { v[j] = v[j] * r1; v2u w; w.x = pk2(v[j][0], v[j][1]); w.y = pk2(v[j][2], v[j][3]); *(LAS v2u*)(XST + ri * XSP + (lane + 64 * j) * 8) = w; }
            {
                float am = 0.f;
#pragma unroll
                for (int j = 0; j < 4; ++j) am = fmaxf(am, fmaxf(fmaxf(fabsf(v[j][0]), fabsf(v[j][1])), fmaxf(fabsf(v[j][2]), fabsf(v[j][3]))));
                am = wave_max(am); const float qa = am > 0.f ? 127.0f / am : 0.f;
                if (lane == 0) ((float*)(ws + WS_SA))[m] = am * (1.0f / 127.0f);
#pragma unroll
                for (int j = 0; j < 4; ++j) ((GAS unsigned*)(ws + WS_XA8 + (size_t)m * DM))[lane + 64 * j] = pk4_i8(v[j][0] * qa, v[j][1] * qa, v[j][2] * qa, v[j][3] * qa); }
        } }
        LDS_WAIT(); asm volatile("" ::: "memory");
        {
            const int r = lane & 15, q = lane >> 4;
            const LAS unsigned char* ap = XST + (r & 3) * XSP + q * 16;
            f32x4 acc = {0.f, 0.f, 0.f, 0.f};
#pragma unroll
            for (int ks = 0; ks < 32; ++ks) { const bf16x8 afr = *(const LAS bf16x8*)(ap + ks * 64); const bf16x8 bfr = *(const LAS bf16x8*)(GWB + r * GP + ks * 32 + q * 8);
                acc = __builtin_amdgcn_mfma_f32_16x16x32_bf16(afr, bfr, acc, 0, 0, 0); }
            const int jg = lane & 15; const float gb = jg < 8 ? P.ml_igate_bias[jg] : P.ml_fgate_bias[jg - 8];
            if (q == 0) {
#pragma unroll
                for (int reg = 0; reg < 4; ++reg) { const int mm = mb + reg * NGW; if (mm < T) {
                    const float z = acc[reg] + gb;
                    if (jg < 8) ((float*)(ws + WS_LOGI))[(size_t)mm * 8 + jg] = z;
                    else ((float*)(ws + WS_LOGF))[(size_t)mm * 8 + jg - 8] = fminf(z, 0.f) - log1pf(expf(-fabsf(z))); } }
            }
            LDS_WAIT(); asm volatile("" ::: "memory");
        }
        }
    }
}
}

__device__ __forceinline__ void p2_vt(const Ptrs& P, int vcu, int G) {
    FRESH_TID();
    const int gw = vcu * NWAVES + wave, NGW = G * NWAVES;
    unsigned char* ws = P.ws;
    for (int it = gw; it < BATCH * 2 * (SEQ / 64); it += NGW) {
        const int b = it >> 8, kvh = (it >> 7) & 1, t = it & 127;
        const unsigned short* src = (const unsigned short*)(ws + WS_AV) + ((size_t)b * SEQ + t * 64) * 128 + kvh * 64 + lane;
#pragma unroll
        for (int c = 0; c < 4; ++c) {
            float v[16];
#pragma unroll
            for (int j = 0; j < 16; ++j) { const int sl = 16 * c + j, hi = sl >> 5, jj = sl & 31, r = jj & 15, key = (r & 3) + 8 * (r >> 2) + 4 * hi + (jj >> 4) * 32;
                v[j] = fminf(fmaxf(__builtin_bit_cast(float, (unsigned)src[(size_t)key * 128] << 16), -448.0f), 448.0f); }
            v4u o;
            { int w = 0; w = __builtin_amdgcn_cvt_pk_fp8_f32(v[0], v[1], w, false); w = __builtin_amdgcn_cvt_pk_fp8_f32(v[2], v[3], w, true); o.x = (unsigned)w; }
            { int w = 0; w = __builtin_amdgcn_cvt_pk_fp8_f32(v[4], v[5], w, false); w = __builtin_amdgcn_cvt_pk_fp8_f32(v[6], v[7], w, true); o.y = (unsigned)w; }
            { int w = 0; w = __builtin_amdgcn_cvt_pk_fp8_f32(v[8], v[9], w, false); w = __builtin_amdgcn_cvt_pk_fp8_f32(v[10], v[11], w, true); o.z = (unsigned)w; }
            { int w = 0; w = __builtin_amdgcn_cvt_pk_fp8_f32(v[12], v[13], w, false); w = __builtin_amdgcn_cvt_pk_fp8_f32(v[14], v[15], w, true); o.w = (unsigned)w; }
            *(GAS v4u*)(ws + WS_AV8T + ((size_t)it * 64 + lane) * 64 + c * 16) = o;
        }
    }
}

__device__ __forceinline__ void p2_rows(const Ptrs& P, int vcu, int G) {
    FRESH_TID();
    const int gw = vcu * NWAVES + wave, NGW = G * NWAVES;
    unsigned char* ws = P.ws;
    const int l7 = lane & 7, d0 = l7 * 8;
    float invf[4];
#pragma unroll
    for (int p = 0; p < 4; ++p) invf[p] = exp2f(-(float)((l7 & 3) * 4 + p) * (13.287712379549449f / 16.0f));
    float gk[8];
#pragma unroll
    for (int e = 0; e < 8; ++e) gk[e] = P.att_k_gain[d0 + e];
    for (int m4 = gw * 4; m4 < T; m4 += NGW * 4) {
        const int m = m4 + (lane >> 4);
        const int pos = m & (SEQ - 1);
        const float pid = (l7 < 4) ? (float)(pos >> 6) : (float)(pos & 63);
        float cs[4], sn[4];
#pragma unroll
        for (int p = 0; p < 4; ++p) { float rev = pid * invf[p] * 0.15915494309189535f; rev -= floorf(rev); sn[p] = __builtin_amdgcn_sinf(rev); cs[p] = __builtin_amdgcn_cosf(rev); }
        GAS v4u* kp = (GAS v4u*)(ws + WS_AK + (size_t)m * 128 * 2) + (lane & 15);
        const v4u raw = __builtin_nontemporal_load((const v4u*)kp); float f[8];
        f[0] = bflo(raw.x); f[1] = bfhi(raw.x); f[2] = bflo(raw.y); f[3] = bfhi(raw.y); f[4] = bflo(raw.z); f[5] = bfhi(raw.z); f[6] = bflo(raw.w); f[7] = bfhi(raw.w);
        float ss = 0.f;
#pragma unroll
        for (int e = 0; e < 8; ++e) ss += f[e] * f[e];
        ss += dpp_f<0xB1>(ss); ss += dpp_f<0x4E>(ss); ss += dpp_f<0x141>(ss);
        const float rs = 1.0f / sqrtf(ss * (1.0f / 64.0f) + NORM_EPS);
#pragma unroll
        for (int e = 0; e < 8; ++e) f[e] = f[e] * rs * gk[e];
        float rt[8];
#pragma unroll
        for (int p = 0; p < 4; ++p) { rt[2 * p] = f[2 * p] * cs[p] - f[2 * p + 1] * sn[p]; rt[2 * p + 1] = f[2 * p] * sn[p] + f[2 * p + 1] * cs[p]; }
#pragma unroll
        for (int e = 0; e < 8; ++e) rt[e] = fminf(fmaxf(rt[e], -448.0f), 448.0f);
        int w0 = 0, w1 = 0;
        w0 = __builtin_amdgcn_cvt_pk_fp8_f32(rt[0], rt[1], w0, false); w0 = __builtin_amdgcn_cvt_pk_fp8_f32(rt[2], rt[3], w0, true);
        w1 = __builtin_amdgcn_cvt_pk_fp8_f32(rt[4], rt[5], w1, false); w1 = __builtin_amdgcn_cvt_pk_fp8_f32(rt[6], rt[7], w1, true);
        v2u o; o.x = (unsigned)w0; o.y = (unsigned)w1;
        *((GAS v2u*)(ws + WS_AK8 + (size_t)m * 128) + (lane & 15)) = o;
    }
}

__device__ __forceinline__ void tr_store2(LAS bf16* DT, int c0, int s, const v4u ra, const v4u rb) {
    LAS unsigned* p = (LAS unsigned*)(DT + c0 * TPITCH + s);
    const unsigned a[4] = {ra.x, ra.y, ra.z, ra.w}, b[4] = {rb.x, rb.y, rb.z, rb.w};
#pragma unroll
    for (int j = 0; j < 4; ++j) { p[(2 * j) * (TPITCH / 2)] = (a[j] & 0xffffu) | (b[j] << 16); p[(2 * j + 1) * (TPITCH / 2)] = (a[j] >> 16) | (b[j] & 0xffff0000u); }
}
__device__ __forceinline__ void unpack8(const v4u r, float (&f)[8]) {
    f[0] = bflo(r.x); f[1] = bfhi(r.x); f[2] = bflo(r.y); f[3] = bfhi(r.y); f[4] = bflo(r.z); f[5] = bfhi(r.z); f[6] = bflo(r.w); f[7] = bfhi(r.w);
}

__device__ __forceinline__ void conv_chunk_to_lds(const Ptrs& P, const bf16* src, int which, int h, int c, size_t t0, LAS bf16* DST, int tid) {
    const int cg = tid & 15, ch0 = which * 512 + h * 128 + cg * 8;
    float w0[8], w1[8], w2[8], cb[8];
#pragma unroll
    for (int e = 0; e < 8; ++e) { w0[e] = P.ml_conv_w[ch0 + e]; w1[e] = P.ml_conv_w[1024 + ch0 + e]; w2[e] = P.ml_conv_w[2048 + ch0 + e]; cb[e] = P.ml_conv_b[ch0 + e]; }
    v4u r0[4], r1[4], r2[4];
#pragma unroll
    for (int it = 0; it < 4; ++it) {
        const int rr = (tid >> 4) + 32 * it; const int pos = c * CHL + rr; const size_t off = (t0 + rr) * 512 + h * 128 + cg * 8;
        const v4u z4 = {0u, 0u, 0u, 0u};
        r1[it] = *(const v4u*)(src + off);
        r0[it] = (pos > 0) ? *(const v4u*)(src + off - 512) : z4;
        r2[it] = (pos < SEQ - 1) ? *(const v4u*)(src + off + 512) : z4;
    }
#pragma unroll
    for (int it = 0; it < 4; ++it) {
        const int rr = (tid >> 4) + 32 * it;
        float x0[8], x1[8], x2[8], y[8]; unpack8(r0[it], x0); unpack8(r1[it], x1); unpack8(r2[it], x2);
#pragma unroll
        for (int e = 0; e < 8; ++e) { float v = w0[e] * x0[e] + w1[e] * x1[e] + w2[e] * x2[e] + cb[e]; v = v * fsigmoid(v); y[e] = which ? v * 0.08838834764831845f : v; }
        v4u o; o.x = pk2(y[0], y[1]); o.y = pk2(y[2], y[3]); o.z = pk2(y[4], y[5]); o.w = pk2(y[6], y[7]);
        *(LAS v4u*)(DST + rr * TPITCH + cg * 8) = o;
    }
}
__device__ __forceinline__ void p2_mlstm_item(const Ptrs& P, LAS unsigned char* lds, int item) {
    FRESH_TID();
    unsigned char* ws = P.ws;
    const int b = item >> 8, h = (item >> 6) & 3, c = item & 63;
    const size_t t0 = (size_t)b * SEQ + (size_t)c * CHL;
    LAS bf16* KS = (LAS bf16*)lds; LAS bf16* VT = (LAS bf16*)(lds + TILE_B); LAS bf16* KWT = (LAS bf16*)(lds + 2 * TILE_B); LAS float* WV = (LAS float*)(lds + 3 * TILE_B);
    conv_chunk_to_lds(P, (const bf16*)(ws + WS_MK), 1, h, c, t0, KS, tid);
    {
    if (wave < 2) {
        const int dir = wave, s0 = 2 * lane; const int chain = ((b * MLH + h) << 1) | dir;
        const float* LI = (const float*)(ws + WS_LOGI); const float* LF = (const float*)(ws + WS_LOGF);
        const float li0 = LI[(t0 + s0) * 8 + dir * 4 + h], li1 = LI[(t0 + s0 + 1) * 8 + dir * 4 + h];
        const float lf0 = LF[(t0 + s0) * 8 + dir * 4 + h], lf1 = LF[(t0 + s0 + 1) * 8 + dir * 4 + h];
        const float Pf = wave_incl_add(lf0 + lf1, lane), tot = __shfl(Pf, 63);
        float cum0, cum1;
        if (dir == 0) { cum0 = Pf - lf1; cum1 = Pf; } else { cum0 = tot - (Pf - lf1) + lf0; cum1 = tot - Pf + lf1; }
        const float a0 = tot - cum0 + li0, a1 = tot - cum1 + li1;
        const float mloc = wave_max(fmaxf(a0, a1));
        WV[dir * 128 + s0] = fexp(a0 - mloc); WV[dir * 128 + s0 + 1] = fexp(a1 - mloc);
        if (lane == 0) { float* SC = (float*)(ws + WS_SCAL) + (size_t)(chain * NCHUNK + c) * 2; SC[0] = tot; SC[1] = mloc; }
    }
#pragma unroll
    for (int it = 0; it < 2; ++it) { const int idx = tid + NTHR * it, sp2 = (idx & 63) * 2, eg = idx >> 6;
        const bf16* src = (const bf16*)(ws + WS_MV) + (t0 + sp2) * 512 + h * 128 + eg * 8;
        tr_store2(VT, eg * 8, sp2, *(const v4u*)src, *(const v4u*)(src + 512)); }
    }
    __syncthreads();
    for (int dir = 0; dir < 2; ++dir) {
        const int chain = ((b * MLH + h) << 1) | dir; const size_t itx = (size_t)chain * NCHUNK + c;
#pragma unroll
        for (int it = 0; it < 2; ++it) { const int idx = tid + NTHR * it, sp2 = (idx & 63) * 2, dg = idx >> 6;
            const v4u ra = *(const LAS v4u*)(KS + sp2 * TPITCH + dg * 8), rb = *(const LAS v4u*)(KS + (sp2 + 1) * TPITCH + dg * 8);
            const float wa = WV[dir * 128 + sp2], wb = WV[dir * 128 + sp2 + 1]; float fa[8], fb[8]; unpack8(ra, fa); unpack8(rb, fb);
            v4u qa, qb;
            qa.x = pk2(fa[0] * wa, fa[1] * wa); qa.y = pk2(fa[2] * wa, fa[3] * wa); qa.z = pk2(fa[4] * wa, fa[5] * wa); qa.w = pk2(fa[6] * wa, fa[7] * wa);
            qb.x = pk2(fb[0] * wb, fb[1] * wb); qb.y = pk2(fb[2] * wb, fb[3] * wb); qb.z = pk2(fb[4] * wb, fb[5] * wb); qb.w = pk2(fb[6] * wb, fb[7] * wb);
            tr_store2(KWT, dg * 8, sp2, qa, qb); }
        { const int d = tid & 127, part = tid >> 7; float a = 0.f;
#pragma unroll 8
          for (int s2 = part * 32; s2 < part * 32 + 32; ++s2) a += WV[dir * 128 + s2] * bf2f(KS[s2 * TPITCH + d]);
          WV[256 + part * 128 + d] = a; }
        __syncthreads();
        if (tid < 128) ((float*)(ws + WS_DN))[itx * 128 + tid] = (WV[256 + tid] + WV[384 + tid]) + (WV[512 + tid] + WV[640 + tid]);
        __syncthreads();
        f32x4 acc[8];
#pragma unroll
        for (int nt = 0; nt < 8; ++nt) acc[nt] = (f32x4){0.f, 0.f, 0.f, 0.f};
        wave_gemm<128>(KWT, wave * 16, VT, acc, lane);
        bf16* CS = (bf16*)(ws + WS_CST) + itx * 16384;
#pragma unroll
        for (int nt = 0; nt < 8; ++nt) { v2u o; o.x = pk2(acc[nt][0], acc[nt][1]); o.y = pk2(acc[nt][2], acc[nt][3]);
            *(v2u*)(CS + (nt * 16 + (lane & 15)) * 128 + wave * 16 + (lane >> 4) * 4) = o; }
        __syncthreads();
    }
}

__device__ __forceinline__ void p3_scan(const Ptrs& P, LAS unsigned char* lds, int vcu, int G) {
    FRESH_TID();
    unsigned char* ws = P.ws;
    const float* SC = (const float*)(ws + WS_SCAL); float* MP = (float*)(ws + WS_MPREV);
    LAS float* BT = (LAS float*)lds; LAS float* ML = BT + 64; LAS float* AL = BT + 128; LAS float* BE = BT + 192; LAS float* MPV = BT + 256;
    for (int u = vcu; u < 256; u += G) {
        const int chain = u >> 3, seg = u & 7, dir = chain & 1;
        __syncthreads();
        if (tid < 64) { const int c = dir ? (NCHUNK - 1 - tid) : tid; const size_t itx = (size_t)chain * NCHUNK + c; BT[tid] = SC[itx * 2]; ML[tid] = SC[itx * 2 + 1]; }
        __syncthreads();
        if (tid == 0) { float m = 0.f;
            for (int st = 0; st < NCHUNK; ++st) { const float btot = BT[st], mloc = ML[st]; const float mnew = fmaxf(btot + m, mloc); MPV[st] = m; AL[st] = fexp(btot + m - mnew); BE[st] = fexp(mloc - mnew); m = mnew; } }
        __syncthreads();
        {
            bf16* base = (bf16*)(ws + WS_CST) + (size_t)chain * NCHUNK * 16384 + seg * 2048 + tid * 4;
            float C0 = 0.f, C1 = 0.f, C2 = 0.f, C3 = 0.f;
#pragma unroll 1
            for (int half = 0; half < 2; ++half) {
                v2u d[32];
#pragma unroll
                for (int k = 0; k < 32; ++k) { const int st = half * 32 + k, c = dir ? (NCHUNK - 1 - st) : st; d[k] = *(const v2u*)(base + (size_t)c * 16384); }
#pragma unroll
                for (int k = 0; k < 32; ++k) { const int st = half * 32 + k, c = dir ? (NCHUNK - 1 - st) : st;
                    v2u o; o.x = pk2(C0, C1); o.y = pk2(C2, C3); *(v2u*)(base + (size_t)c * 16384) = o;
                    const float al = AL[st], be = BE[st];
                    C0 = al * C0 + be * bflo(d[k].x); C1 = al * C1 + be * bfhi(d[k].x); C2 = al * C2 + be * bflo(d[k].y); C3 = al * C3 + be * bfhi(d[k].y); }
            }
            if (seg == 0 && tid < 64) { const int c = dir ? (NCHUNK - 1 - tid) : tid; MP[(size_t)chain * NCHUNK + c] = MPV[tid]; }
        }
        if (seg == 0 && tid < 128) {
            float* base = (float*)(ws + WS_DN) + (size_t)chain * NCHUNK * 128 + tid;
            float n = 0.f;
#pragma unroll 1
            for (int half = 0; half < 2; ++half) {
                float d[32];
#pragma unroll
                for (int k = 0; k < 32; ++k) { const int st = half * 32 + k, c = dir ? (NCHUNK - 1 - st) : st; d[k] = base[(size_t)c * 128]; }
#pragma unroll
                for (int k = 0; k < 32; ++k) { const int st = half * 32 + k, c = dir ? (NCHUNK - 1 - st) : st; base[(size_t)c * 128] = n; n = AL[st] * n + BE[st] * d[k]; }
            }
        }
    }
    __syncthreads();
}

__device__ __forceinline__ void p4_mlstm_item(const Ptrs& P, LAS unsigned char* lds, int item) {
    FRESH_TID();
    unsigned char* ws = P.ws;
    const int b = item >> 8, h = (item >> 6) & 3, c = item & 63;
    const size_t t0 = (size_t)b * SEQ + (size_t)c * CHL;
    LAS bf16* QS = (LAS bf16*)lds; LAS bf16* KS = (LAS bf16*)(lds + TILE_B); LAS bf16* VT = (LAS bf16*)(lds + 2 * TILE_B); LAS bf16* CT = (LAS bf16*)(lds + 3 * TILE_B);
    LAS bf16* SP = KS;
    LAS float* ARR = (LAS float*)(lds + 4 * TILE_B);
    const int fr = lane & 15, fq = lane >> 4, l0 = wave * 16;
    const size_t itx0 = (size_t)(((b * MLH + h) << 1) | 0) * NCHUNK + c, itx1 = (size_t)(((b * MLH + h) << 1) | 1) * NCHUNK + c;
    conv_chunk_to_lds(P, (const bf16*)(ws + WS_MQ), 0, h, c, t0, QS, tid);
    conv_chunk_to_lds(P, (const bf16*)(ws + WS_MK), 1, h, c, t0, KS, tid);
    v4u ct1[4];
#pragma unroll
    for (int it = 0; it < 4; ++it) { const int idx = tid + NTHR * it, e = idx >> 4, dg = idx & 15; ct1[it] = *(const v4u*)((const bf16*)(ws + WS_CST) + itx1 * 16384 + e * 128 + dg * 8); }
#pragma unroll
    for (int it = 0; it < 4; ++it) { { const int idx = tid + NTHR * it, s = idx >> 4, eg = idx & 15; const size_t off = (t0 + s) * 512 + h * 128 + eg * 8;
        *(LAS v4u*)(CT + s * TPITCH + eg * 8) = *(const v4u*)((const bf16*)(ws + WS_CST) + itx0 * 16384 + s * 128 + eg * 8); }
    }
#pragma unroll
    for (int it = 0; it < 2; ++it) { const int idx = tid + NTHR * it, sp2 = (idx & 63) * 2, eg = idx >> 6;
        const bf16* src = (const bf16*)(ws + WS_MV) + (t0 + sp2) * 512 + h * 128 + eg * 8;
        tr_store2(VT, eg * 8, sp2, *(const v4u*)src, *(const v4u*)(src + 512)); }
    if (tid >= 128 && tid < 384) { const int d = (tid - 128) >> 7, j = (tid - 128) & 127; ARR[d * 896 + 768 + j] = ((const float*)(ws + WS_DN))[(d ? itx1 : itx0) * 128 + j]; }
    if (wave < 2) {
        const int dir = wave, s0 = 2 * lane; LAS float* A = ARR + dir * 896;
        const float* LI = (const float*)(ws + WS_LOGI); const float* LF = (const float*)(ws + WS_LOGF);
        const float li0 = LI[(t0 + s0) * 8 + dir * 4 + h], li1 = LI[(t0 + s0 + 1) * 8 + dir * 4 + h];
        const float lf0 = LF[(t0 + s0) * 8 + dir * 4 + h], lf1 = LF[(t0 + s0 + 1) * 8 + dir * 4 + h];
        const float mp = ((const float*)(ws + WS_MPREV))[dir ? itx1 : itx0];
        const float Pf = wave_incl_add(lf0 + lf1, lane), tot = __shfl(Pf, 63);
        float cum0, cum1, pm0, pm1;
        if (dir == 0) { cum0 = Pf - lf1; cum1 = Pf; } else { cum0 = tot - (Pf - lf1) + lf0; cum1 = tot - Pf + lf1; }
        const float g0 = li0 - cum0, g1 = li1 - cum1;
        if (dir == 0) { const float PM = wave_incl_max(fmaxf(g0, g1), lane); float px = __shfl_up(PM, 1); if (lane == 0) px = -INFINITY; pm0 = fmaxf(px, g0); pm1 = PM; }
        else { const float PM = wave_incl_max_rev(fmaxf(g0, g1), lane); float px = __shfl_down(PM, 1); if (lane == 63) px = -INFINITY; pm1 = fmaxf(px, g1); pm0 = PM; }
        const float mr0 = cum0 + fmaxf(mp, pm0), mr1 = cum1 + fmaxf(mp, pm1);
        A[s0] = cum0; A[s0 + 1] = cum1; A[128 + s0] = li0; A[128 + s0 + 1] = li1; A[256 + s0] = mr0; A[256 + s0 + 1] = mr1;
        A[384 + s0] = fexp(cum0 + mp - mr0); A[384 + s0 + 1] = fexp(cum1 + mp - mr1); A[512 + s0] = fexp(-mr0); A[512 + s0 + 1] = fexp(-mr1);
    }
    __syncthreads();
    {
        const int l = tid >> 2, part = tid & 3; float a0 = 0.f, a1 = 0.f;
#pragma unroll
        for (int j = 0; j < 4; ++j) { const v4u r = *(const LAS v4u*)(QS + l * TPITCH + part * 32 + j * 8); float f[8]; unpack8(r, f);
#pragma unroll
            for (int e = 0; e < 8; ++e) { a0 += f[e] * ARR[768 + part * 32 + j * 8 + e]; a1 += f[e] * ARR[896 + 768 + part * 32 + j * 8 + e]; } }
        a0 += dpp_f<0xB1>(a0); a0 += dpp_f<0x4E>(a0); a1 += dpp_f<0xB1>(a1); a1 += dpp_f<0x4E>(a1);
        if (part == 0) { ARR[640 + l] = a0; ARR[896 + 640 + l] = a1; }
    }
    f32x4 S[8], hs[8], acc[8];
#pragma unroll
    for (int nt = 0; nt < 8; ++nt) { S[nt] = (f32x4){0.f, 0.f, 0.f, 0.f}; acc[nt] = (f32x4){0.f, 0.f, 0.f, 0.f}; }
    wave_gemm<128>(QS, l0, KS, S, lane);
    wave_gemm<128>(QS, l0, CT, acc, lane);
    __syncthreads();
#pragma unroll
    for (int it = 0; it < 4; ++it) { const int idx = tid + NTHR * it, e = idx >> 4, dg = idx & 15; *(LAS v4u*)(CT + e * TPITCH + dg * 8) = ct1[it]; }
#pragma unroll
    for (int dir = 0; dir < 2; ++dir) {
        const LAS float* A = ARR + dir * 896;
        float dint[4] = {0.f, 0.f, 0.f, 0.f};
        float ul[4];
#pragma unroll
        for (int r = 0; r < 4; ++r) { const int l = l0 + fq * 4 + r; ul[r] = (A[l] - A[256 + l]) * 1.4426950408889634f; }
#pragma unroll
        for (int nt = 0; nt < 8; ++nt) {
            const int sx = nt * 16 + fr;
            const bool full = dir ? (nt > wave) : (nt < wave), diag = (nt == wave);
            const bool wanted = dir ? (nt >= (wave & ~1)) : (nt <= (wave | 1));
            if (full || diag) {
                const float gs = (A[128 + sx] - A[sx]) * 1.4426950408889634f;
                float sp[4];
#pragma unroll
                for (int r = 0; r < 4; ++r) { const int l = l0 + fq * 4 + r; float wgt = __builtin_amdgcn_exp2f(ul[r] + gs);
                    if (diag) wgt = (dir ? (sx >= l) : (sx <= l)) ? wgt : 0.f;
                    sp[r] = S[nt][r] * wgt; dint[r] += sp[r]; }
                const unsigned p01 = pk2(sp[0], sp[1]), p23 = pk2(sp[2], sp[3]);
                SP[(l0 + fq * 4 + 0) * TPITCH + sx] = (bf16)(p01 & 0xffffu); SP[(l0 + fq * 4 + 1) * TPITCH + sx] = (bf16)(p01 >> 16);
                SP[(l0 + fq * 4 + 2) * TPITCH + sx] = (bf16)(p23 & 0xffffu); SP[(l0 + fq * 4 + 3) * TPITCH + sx] = (bf16)(p23 >> 16);
            } else if (wanted) {
#pragma unroll
                for (int r = 0; r < 4; ++r) SP[(l0 + fq * 4 + r) * TPITCH + sx] = (bf16)0;
            }
        }
#pragma unroll
        for (int r = 0; r < 4; ++r) { dint[r] += dpp_f<0xB1>(dint[r]); dint[r] += dpp_f<0x4E>(dint[r]); dint[r] += dpp_f<0x141>(dint[r]); dint[r] += dpp_f<0x128>(dint[r]); }
        if (dir == 1) {
            __syncthreads();
#pragma unroll
            for (int nt = 0; nt < 8; ++nt) acc[nt] = (f32x4){0.f, 0.f, 0.f, 0.f};
            wave_gemm<128>(QS, l0, CT, acc, lane);
        }
        float wi[4], dn[4];
#pragma unroll
        for (int r = 0; r < 4; ++r) { const int l = l0 + fq * 4 + r; wi[r] = A[384 + l]; const float den = wi[r] * A[640 + l] + dint[r]; dn[r] = 1.0f / fmaxf(fabsf(den), A[512 + l]); }
#pragma unroll
        for (int nt = 0; nt < 8; ++nt)
#pragma unroll
            for (int r = 0; r < 4; ++r) acc[nt][r] *= wi[r];
        asm volatile("s_waitcnt lgkmcnt(0)" ::: "memory");
        {
            const int kh = wave >> 1;
#pragma unroll
            for (int ks = 0; ks < 4; ++ks) {
                if (dir ? (ks >= kh) : (ks <= kh)) {
                    const bf16x8 a = *(const LAS bf16x8*)(SP + (l0 + fr) * TPITCH + ks * 32 + fq * 8);
#pragma unroll
                    for (int nt = 0; nt < 8; ++nt) { const bf16x8 bb = *(const LAS bf16x8*)(VT + (nt * 16 + fr) * TPITCH + ks * 32 + fq * 8); acc[nt] = __builtin_amdgcn_mfma_f32_16x16x32_bf16(a, bb, acc[nt], 0, 0, 0); }
                }
            }
        }
#pragma unroll
        for (int nt = 0; nt < 8; ++nt)
#pragma unroll
            for (int r = 0; r < 4; ++r) hs[nt][r] = (dir ? hs[nt][r] : 0.f) + acc[nt][r] * dn[r];
    }
    float rs[4];
#pragma unroll
    for (int r = 0; r < 4; ++r) { float ss = 0.f;
#pragma unroll
        for (int nt = 0; nt < 8; ++nt) ss += hs[nt][r] * hs[nt][r];
        ss += dpp_f<0xB1>(ss); ss += dpp_f<0x4E>(ss); ss += dpp_f<0x141>(ss); ss += dpp_f<0x128>(ss);
        rs[r] = 1.0f / sqrtf(ss * (1.0f / 128.0f) + NORM_EPS); }
#pragma unroll
    for (int nt = 0; nt < 8; ++nt) { const int e = nt * 16 + fr; const float og = P.ml_out_gain[h * 128 + e];
#pragma unroll
        for (int r = 0; r < 4; ++r) { const size_t t = t0 + l0 + fq * 4 + r;
            const float o = bf2f(((const bf16*)(ws + WS_MO))[t * 512 + h * 128 + e]);
            const float val = hs[nt][r] * rs[r] * og * fsigmoid(o);
            { int w8 = 0; w8 = __builtin_amdgcn_cvt_pk_fp8_f32(fminf(fmaxf(val * MIX8SCALE, -448.f), 448.f), 0.f, w8, false); (ws + WS_MIX)[t * 1024 + 512 + h * 128 + e] = (unsigned char)(w8 & 0xff); } } }
    __syncthreads();
}

__device__ __forceinline__ int dpp_xor1i(int x) { return __builtin_amdgcn_update_dpp(0, x, 0xB1, 0xF, 0xF, false); }
__device__ __forceinline__ int dpp_xor2i(int x) { return __builtin_amdgcn_update_dpp(0, x, 0x4E, 0xF, 0xF, false); }
__device__ __forceinline__ int swz_xor4i(int x) { return __builtin_amdgcn_ds_swizzle(x, 0x101F); }
__device__ __forceinline__ int dpp_ror8i(int x) { return __builtin_amdgcn_update_dpp(0, x, 0x128, 0xF, 0xF, false); }
__device__ __forceinline__ float key2val(unsigned key) { unsigned o = key >> 16; unsigned b = (o & 0x8000u) ? (o & 0x7fffu) : (~o & 0xffffu); _Float16 hv = __builtin_bit_cast(_Float16, (unsigned short)b); return (float)hv; }
__device__ __forceinline__ unsigned umax2(unsigned a, unsigned b) { return a > b ? a : b; }
__device__ __forceinline__ unsigned umin2(unsigned a, unsigned b) { return a > b ? b : a; }
__device__ __forceinline__ void sort16_desc(unsigned (&a)[16]) {
#define CE_(i, j) do { const unsigned hi_ = umax2(a[i], a[j]), lo_ = umin2(a[i], a[j]); a[i] = hi_; a[j] = lo_; } while (0)
    CE_(0, 13); CE_(1, 12); CE_(2, 15); CE_(3, 14); CE_(4, 8); CE_(5, 6); CE_(7, 11); CE_(9, 10);
    CE_(0, 5); CE_(1, 7); CE_(2, 9); CE_(3, 4); CE_(6, 13); CE_(8, 14); CE_(10, 15); CE_(11, 12);
    CE_(0, 1); CE_(2, 3); CE_(4, 5); CE_(6, 8); CE_(7, 9); CE_(10, 11); CE_(12, 13); CE_(14, 15);
    CE_(0, 2); CE_(1, 3); CE_(4, 10); CE_(5, 11); CE_(6, 7); CE_(8, 9); CE_(12, 14); CE_(13, 15);
    CE_(1, 2); CE_(3, 12); CE_(4, 6); CE_(5, 7); CE_(8, 10); CE_(9, 11); CE_(13, 14);
    CE_(1, 4); CE_(2, 6); CE_(5, 8); CE_(7, 10); CE_(9, 13); CE_(11, 14);
    CE_(2, 4); CE_(3, 6); CE_(9, 12); CE_(11, 13);
    CE_(3, 5); CE_(6, 8); CE_(7, 9); CE_(10, 12);
    CE_(3, 4); CE_(5, 6); CE_(7, 8); CE_(9, 10); CE_(11, 12);
    CE_(6, 7); CE_(8, 9);
#undef CE_
}
__device__ __forceinline__ void merge16_desc(unsigned (&top)[16], const unsigned (&blk)[16]) {
#pragma unroll
    for (int i = 0; i < 16; ++i) top[i] = umax2(top[i], blk[15 - i]);
#pragma unroll
    for (int j = 8; j > 0; j >>= 1)
#pragma unroll
        for (int i = 0; i < 16; ++i) { const int l = i ^ j; if (l > i) { const unsigned hi = umax2(top[i], top[l]), lo = umin2(top[i], top[l]); top[i] = hi; top[l] = lo; } }
}
__device__ __forceinline__ void topk_half(const unsigned short* sc, unsigned (&v)[16]) {
#pragma unroll 1
    for (int blk = 0; blk < 8; ++blk) {
        const v4u r0 = __builtin_nontemporal_load((const v4u*)(sc + (2 * blk) * 512)), r1 = __builtin_nontemporal_load((const v4u*)(sc + (2 * blk + 1) * 512));
        const unsigned w[8] = {r0.x, r0.y, r0.z, r0.w, r1.x, r1.y, r1.z, r1.w};
        unsigned b[16];
        const unsigned base = 127u - 16u * (unsigned)blk;
#pragma unroll
        for (int e = 0; e < 8; ++e) { b[2 * e] = (w[e] << 16) | (base - 2u * e); b[2 * e + 1] = (w[e] & 0xffff0000u) | (base - 2u * e - 1u); }
        sort16_desc(b);
        if (blk == 0) {
#pragma unroll
            for (int p = 0; p < 16; ++p) v[p] = b[p];
        } else merge16_desc(v, b);
    }
}
__device__ __forceinline__ unsigned ordf(float s) { const unsigned sb = __builtin_bit_cast(unsigned, s); return (sb & 0x80000000u) ? ~sb : (sb | 0x80000000u); }
__device__ __forceinline__ void p7_topk(const Ptrs& P, LAS unsigned char* lds, int vcu, int G) {
    FRESH_TID();
    unsigned char* ws = P.ws;
    LAS unsigned char* myl = lds + tid * 36;
    for (int t = vcu * NWAVES + wave; t < T; t += G * NWAVES) {
        const v4u* hp = (const v4u*)((const bf16*)(ws + WS_HB) + (size_t)t * DM + 16 * lane);
        const v4u ha = hp[0], hb = hp[1];
        float f[16];
        f[0] = bflo(ha.x); f[1] = bfhi(ha.x); f[2] = bflo(ha.y); f[3] = bfhi(ha.y); f[4] = bflo(ha.z); f[5] = bfhi(ha.z); f[6] = bflo(ha.w); f[7] = bfhi(ha.w);
        f[8] = bflo(hb.x); f[9] = bfhi(hb.x); f[10] = bflo(hb.y); f[11] = bfhi(hb.y); f[12] = bflo(hb.z); f[13] = bfhi(hb.z); f[14] = bflo(hb.w); f[15] = bfhi(hb.w);
        float hm = 0.f;
#pragma unroll
        for (int e = 0; e < 16; ++e) hm = fmaxf(hm, fabsf(f[e]));
        hm = fmaxf(hm, __builtin_bit_cast(float, dpp_xor1i(__builtin_bit_cast(int, hm)))); hm = fmaxf(hm, __builtin_bit_cast(float, dpp_xor2i(__builtin_bit_cast(int, hm))));
        hm = fmaxf(hm, __builtin_bit_cast(float, swz_xor4i(__builtin_bit_cast(int, hm)))); hm = fmaxf(hm, __builtin_bit_cast(float, dpp_ror8i(__builtin_bit_cast(int, hm))));
        const float xs = hm > 0.f ? 119.0f / hm : 0.f;
        unsigned nh[16], nl[16];
#pragma unroll
        for (int e = 0; e < 16; ++e) { const int xi = (int)rintf(f[e] * xs); const int xh = (xi + 8) >> 4, xl = xi - 16 * xh; nh[e] = (unsigned)xh & 0xfu; nl[e] = (unsigned)xl & 0xfu; }
        v2u oh, ol;
        oh.x = (nh[0] | (nh[8] << 4)) | ((nh[1] | (nh[9] << 4)) << 8) | ((nh[2] | (nh[10] << 4)) << 16) | ((nh[3] | (nh[11] << 4)) << 24);
        oh.y = (nh[4] | (nh[12] << 4)) | ((nh[5] | (nh[13] << 4)) << 8) | ((nh[6] | (nh[14] << 4)) << 16) | ((nh[7] | (nh[15] << 4)) << 24);
        ol.x = (nl[0] | (nl[8] << 4)) | ((nl[1] | (nl[9] << 4)) << 8) | ((nl[2] | (nl[10] << 4)) << 16) | ((nl[3] | (nl[11] << 4)) << 24);
        ol.y = (nl[4] | (nl[12] << 4)) | ((nl[5] | (nl[13] << 4)) << 8) | ((nl[6] | (nl[14] << 4)) << 16) | ((nl[7] | (nl[15] << 4)) << 24);
        *(v2u*)(ws + WS_XQ + (size_t)t * DM + 8 * lane) = oh; *(v2u*)(ws + WS_XQ + (size_t)t * DM + 512 + 8 * lane) = ol;
        if ((lane & 15) == 0) ((float*)(ws + WS_XS))[(size_t)t * 4 + (lane >> 4)] = hm * (1.0f / 119.0f);
    }
    for (int wi = vcu * NWAVES + wave; wi < (T / 64) * 8; wi += G * NWAVES) {
        const int tb = wi >> 3, head = wi & 7; const int item = (tb * 64 + lane) * 8 + head;
        const unsigned short* sc = (const unsigned short*)(ws + WS_SC) + ((size_t)(tb * 16 + head * 2) * 16 * 64 + lane) * 8;
        unsigned ka[16], kb[16];
        topk_half(sc, ka); topk_half(sc + 16 * 64 * 8, kb);
        float av[16], bv[16];
#pragma unroll
        for (int i = 0; i < 16; ++i) { av[i] = key2val(ka[i]); bv[i] = key2val(kb[i]); }
#pragma unroll
        for (int q = 0; q < 4; ++q) {
            ((LAS unsigned*)myl)[q] = ((127u - (ka[4 * q] & 0x7fu))) | ((127u - (ka[4 * q + 1] & 0x7fu)) << 8) | ((127u - (ka[4 * q + 2] & 0x7fu)) << 16) | ((127u - (ka[4 * q + 3] & 0x7fu)) << 24);
            ((LAS unsigned*)myl)[4 + q] = ((127u - (kb[4 * q] & 0x7fu))) | ((127u - (kb[4 * q + 1] & 0x7fu)) << 8) | ((127u - (kb[4 * q + 2] & 0x7fu)) << 16) | ((127u - (kb[4 * q + 3] & 0x7fu)) << 24);
        }
#define CKEY(i, j) ((ordf(av[i] + bv[j]) & 0xffffff00u) | (255u - (unsigned)(16 * (i) + (j))))
        unsigned top[16], blk[16];
#pragma unroll
        for (int j = 0; j < 16; ++j) top[j] = CKEY(0, j);
#pragma unroll
        for (int j = 0; j < 16; ++j) blk[j] = 0u;
#pragma unroll
        for (int j = 0; j < 8; ++j) blk[j] = CKEY(1, j);
        merge16_desc(top, blk);
#pragma unroll
        for (int j = 0; j < 16; ++j) blk[j] = 0u;
#pragma unroll
        for (int j = 0; j < 5; ++j) blk[j] = CKEY(2, j);
        merge16_desc(top, blk);
#pragma unroll
        for (int j = 0; j < 16; ++j) blk[j] = 0u;
#pragma unroll
        for (int j = 0; j < 4; ++j) blk[j] = CKEY(3, j);
        merge16_desc(top, blk);
#pragma unroll
        for (int j = 0; j < 16; ++j) blk[j] = 0u;
#pragma unroll
        for (int j = 0; j < 3; ++j) blk[j] = CKEY(4, j);
        merge16_desc(top, blk);
        blk[0] = CKEY(5, 0); blk[1] = CKEY(5, 1); blk[2] = CKEY(6, 0); blk[3] = CKEY(6, 1); blk[4] = CKEY(7, 0); blk[5] = CKEY(7, 1);
        blk[6] = CKEY(8, 0); blk[7] = CKEY(9, 0); blk[8] = CKEY(10, 0); blk[9] = CKEY(11, 0); blk[10] = CKEY(12, 0); blk[11] = CKEY(13, 0); blk[12] = CKEY(14, 0); blk[13] = CKEY(15, 0); blk[14] = 0u; blk[15] = 0u;
        sort16_desc(blk);
        merge16_desc(top, blk);
#undef CKEY
        float sv[16]; float ssum = 0.f;
#pragma unroll
        for (int p = 0; p < 16; ++p) { const unsigned o = top[p] & 0xffffff00u; sv[p] = (o & 0x80000000u) ? __builtin_bit_cast(float, o & 0x7fffffffu) : __builtin_bit_cast(float, ~o & 0xffffff00u); }
        float r2;
        { const f32x4* sp = (const f32x4*)((const float*)(ws + WS_SSQ) + (size_t)(tb * 64 + lane) * 16);
          const f32x4 s0 = sp[0], s1 = sp[1], s2 = sp[2], s3 = sp[3];
          const float ss = ((s0[0] + s0[1]) + (s0[2] + s0[3])) + ((s1[0] + s1[1]) + (s1[2] + s1[3])) + ((s2[0] + s2[1]) + (s2[2] + s2[3])) + ((s3[0] + s3[1]) + (s3[2] + s3[3]));
          r2 = 1.0f / sqrtf(ss * (1.0f / DM) + NORM_EPS); }
        const float mx = sv[0];
#pragma unroll
        for (int p = 0; p < 16; ++p) { sv[p] = fexp((sv[p] - mx) * r2); ssum += sv[p]; }
        const float inv = 1.0f / ssum;
        asm volatile("s_waitcnt lgkmcnt(0)" ::: "memory");
        unsigned short* IDS = (unsigned short*)(ws + WS_IDS) + (size_t)item * 16; float* GT = (float*)(ws + WS_GATES) + (size_t)item * 16;
        unsigned idw[8];
#pragma unroll
        for (int z = 0; z < 8; ++z) {
            const unsigned p0 = 255u - (top[2 * z] & 0xffu), p1 = 255u - (top[2 * z + 1] & 0xffu);
            const unsigned i0 = (unsigned)myl[p0 >> 4] * 128u + (unsigned)myl[16 + (p0 & 15u)], i1 = (unsigned)myl[p1 >> 4] * 128u + (unsigned)myl[16 + (p1 & 15u)];
            idw[z] = i0 | (i1 << 16);
        }
        *((v4u*)IDS) = (v4u){idw[0], idw[1], idw[2], idw[3]}; *((v4u*)IDS + 1) = (v4u){idw[4], idw[5], idw[6], idw[7]};
#pragma unroll
        for (int q = 0; q < 4; ++q) {
            f32x4 gv; gv[0] = sv[4 * q] * inv; gv[1] = sv[4 * q + 1] * inv; gv[2] = sv[4 * q + 2] * inv; gv[3] = sv[4 * q + 3] * inv;
            *((f32x4*)GT + q) = gv;
        }
        asm volatile("s_waitcnt lgkmcnt(0)" ::: "memory");
    }
}

struct Grp { int grp, gidx, gsize; };
__device__ __forceinline__ Grp peer_group(int vcu, int G) { Grp g; if (G % 8 == 0) { g.grp = vcu / (G / 8); g.gidx = vcu % (G / 8); g.gsize = G / 8; } else { g.grp = vcu % 8; g.gidx = vcu / 8; g.gsize = (G - g.grp + 7) / 8; } return g; }
__device__ __forceinline__ void p8_ids(const unsigned char* ws, int t, unsigned ug, int (&ids)[16]) {
    const int tc = t < T ? t : T - 1; const v4u* IDS = (const v4u*)((const unsigned short*)(ws + WS_IDS) + (size_t)tc * 128) + 2u * ug;
#pragma unroll
    for (int q = 0; q < 2; ++q) { const v4u v = IDS[q];
        ids[8 * q] = (int)(v.x & 0xffffu); ids[8 * q + 1] = (int)(v.x >> 16); ids[8 * q + 2] = (int)(v.y & 0xffffu); ids[8 * q + 3] = (int)(v.y >> 16);
        ids[8 * q + 4] = (int)(v.z & 0xffffu); ids[8 * q + 5] = (int)(v.z >> 16); ids[8 * q + 6] = (int)(v.w & 0xffffu); ids[8 * q + 7] = (int)(v.w >> 16); }
}
__device__ __forceinline__ void p8_rows(const unsigned char* tab, unsigned toff, const int (&ids)[16], v4u (&rr)[16]) {
#pragma unroll
    for (int i = 0; i < 16; ++i) rr[i] = *(const v4u*)(tab + ((unsigned)ids[i] * 128u + toff));
}
__device__ __forceinline__ void p8a_hx(const float* H, int t, int col0, f32x4 (&hx)[4]) {
    const int tc = t < T ? t : T - 1;
#pragma unroll
    for (int q = 0; q < 4; ++q) hx[q] = *(const f32x4*)(H + (size_t)tc * DM + col0 + 4 * q);
}
__device__ __forceinline__ void p8a_down(const Ptrs& P, int vcu, int G) {
    FRESH_TID();
    unsigned char* ws = P.ws;
    const Grp gr = peer_group(vcu, G);
    const int slice = gr.grp >> 1, par = gr.grp & 1;
    const int g = lane >> 3, kq = lane & 7, col0 = slice * 256 + kq * 32;
    const unsigned char* tab = ws + WS_DOWN8 + (size_t)slice * PEER_E * 128;
    const unsigned toff = (unsigned)kq * 16u, ug = (unsigned)g;
    bf16* PART = (bf16*)(ws + WS_PART) + (size_t)slice * T * 128;
    const int tstep = 2 * gr.gsize * NWAVES; int t = par + 2 * (gr.gidx * NWAVES + wave);
    if (t >= T) return;
    const int ib = 8 * (kq & 1) + 4 * ((kq >> 1) & 1) + 2 * ((kq >> 2) & 1);
    const unsigned char* XQ = ws + WS_XQ; const float* XS = (const float*)(ws + WS_XS);
    int idn[16]; v4u rr[16]; v4u xa, xb, xan, xbn; float xdq, xdqn;
    const unsigned xoffb = (unsigned)slice * 128u + (unsigned)kq * 16u;
    p8_ids(ws, t, ug, idn); p8_rows(tab, toff, idn, rr);
    { const unsigned char* xp = XQ + (size_t)t * DM + xoffb; xa = *(const v4u*)xp; xb = *(const v4u*)(xp + 512); xdq = XS[(size_t)t * 4 + slice]; }
    p8_ids(ws, t + tstep, ug, idn);
    for (; t < T; t += tstep) {
        { const int tn = t + tstep, tc = tn < T ? tn : T - 1; const unsigned char* xp = XQ + (size_t)tc * DM + xoffb; xan = __builtin_nontemporal_load((const v4u*)xp); xbn = __builtin_nontemporal_load((const v4u*)(xp + 512));        xdqn = XS[(size_t)tc * 4 + slice]; }
        int id2[16]; p8_ids(ws, t + 2 * tstep, ug, id2);
        const int xh[4] = {(int)xa.x, (int)xa.y, (int)xa.z, (int)xa.w}, xl[4] = {(int)xb.x, (int)xb.y, (int)xb.z, (int)xb.w};
        int res[16];
#pragma unroll
        for (int i = 0; i < 16; ++i) {
            const int w0 = (int)rr[i].x, w1 = (int)rr[i].y, w2 = (int)rr[i].z, w3 = (int)rr[i].w;
            int ah = __builtin_amdgcn_sdot8(w0, xh[0], 0, false); ah = __builtin_amdgcn_sdot8(w1, xh[1], ah, false); ah = __builtin_amdgcn_sdot8(w2, xh[2], ah, false); ah = __builtin_amdgcn_sdot8(w3, xh[3], ah, false);
            int al = __builtin_amdgcn_sdot8(w0, xl[0], 0, false); al = __builtin_amdgcn_sdot8(w1, xl[1], al, false); al = __builtin_amdgcn_sdot8(w2, xl[2], al, false); al = __builtin_amdgcn_sdot8(w3, xl[3], al, false);
            res[i] = 16 * ah + al;
            rr[i] = *(const v4u*)(tab + ((unsigned)idn[i] * 128u + toff));
            idn[i] = id2[i];
            asm volatile("" : "+v"(res[i]) :: "memory");
            __builtin_amdgcn_sched_barrier(0);
        }
        int q8[8], q4[4], q2[2];
        { const bool bt = lane & 1;
#pragma unroll
          for (int i = 0; i < 8; ++i) { const int send = bt ? res[i] : res[i + 8], keep = bt ? res[i + 8] : res[i]; q8[i] = keep + dpp_xor1i(send); } }
        { const bool bt = lane & 2;
#pragma unroll
          for (int i = 0; i < 4; ++i) { const int send = bt ? q8[i] : q8[i + 4], keep = bt ? q8[i + 4] : q8[i]; q4[i] = keep + dpp_xor2i(send); } }
        { const bool bt = lane & 4;
#pragma unroll
          for (int i = 0; i < 2; ++i) { const int send = bt ? q4[i] : q4[i + 2], keep = bt ? q4[i + 2] : q4[i]; q2[i] = keep + swz_xor4i(send); } }
        __builtin_nontemporal_store(pk2((float)q2[0] * xdq, (float)q2[1] * xdq), (unsigned*)(PART + (size_t)t * 128 + 16 * g + ib));
        xa = xan; xb = xbn; xdq = xdqn;
    }
}
__device__ __forceinline__ void p8b_act(const Ptrs& P, int vcu, int G) {
    FRESH_TID();
    const int gw = vcu * NWAVES + wave, NGW = G * NWAVES;
    unsigned char* ws = P.ws;
    const bf16* PART = (const bf16*)(ws + WS_PART); const float* SD = (const float*)(ws + WS_SD); const float* SU = (const float*)(ws + WS_SU);
    for (int tb = gw; tb < T; tb += 4 * NGW) {
        float c[4][2], cm[4];
        int ids[4][2]; float av[4][2], gt[4][2], sq[4];
#pragma unroll
        for (int k = 0; k < 4; ++k) { const int t = tb + k * NGW < T ? tb + k * NGW : tb;
            sq[k] = lane < 16 ? ((const float*)(ws + WS_SSQ))[(size_t)t * 16 + lane] : 0.f;
#pragma unroll
            for (int hh = 0; hh < 2; ++hh) { const size_t i = (size_t)t * 128 + hh * 64 + lane; float a = 0.f;
#pragma unroll
                for (int sl = 0; sl < 4; ++sl) a += bf2f(__builtin_nontemporal_load(PART + (size_t)sl * T * 128 + i));
                av[k][hh] = a; ids[k][hh] = (int)((const unsigned short*)(ws + WS_IDS))[i]; gt[k][hh] = __builtin_nontemporal_load((const float*)(ws + WS_GATES) + i); } }
#pragma unroll
        for (int k = 0; k < 4; ++k) {
            const float r2 = 1.0f / sqrtf(wave_sum(sq[k]) * (1.0f / DM) + NORM_EPS);
#pragma unroll
            for (int hh = 0; hh < 2; ++hh) { const float a = av[k][hh] * SD[ids[k][hh]] * r2;
                const float act = 0.5f * a * (1.0f + erff(a * 0.7071067811865476f));
                c[k][hh] = gt[k][hh] * act * SU[ids[k][hh]]; }
            cm[k] = wave_max(fmaxf(fabsf(c[k][0]), fabsf(c[k][1])));
        }
#pragma unroll
        for (int k = 0; k < 4; ++k) { const int t = tb + k * NGW; if (t < T) {
            const float cs = cm[k] > 0.f ? 127.0f / cm[k] : 0.f;
            signed char* C8 = (signed char*)(ws + WS_C8) + (size_t)t * 128;
            C8[lane] = (signed char)(int)rintf(c[k][0] * cs); C8[64 + lane] = (signed char)(int)rintf(c[k][1] * cs);
            const int q0 = (int)rintf(c[k][0] * cs), q1 = (int)rintf(c[k][1] * cs);
            const float csum = wave_sum((float)(q0 + q1));
            if (lane == 0) { ((float*)(ws + WS_CSC))[t] = cm[k] * (1.0f / 127.0f); ((float*)(ws + WS_CSC))[T + t] = 8.0f * csum; } } }
    }
}
__device__ __forceinline__ void p8c_up(const Ptrs& P, int vcu, int G) {
    FRESH_TID();
    typedef int v4i __attribute__((ext_vector_type(4)));
    unsigned char* ws = P.ws;
    const Grp gr = peer_group(vcu, G);
    const int slice = gr.grp >> 1, par = gr.grp & 1;
    const int g = lane >> 3, cq = lane & 7, m = lane & 15, q = lane >> 4;
    const unsigned char* tab = ws + WS_UP8 + (size_t)slice * PEER_E * 128;
    const unsigned toff = (unsigned)cq * 16u, ug = (unsigned)g;
    const int sh = 8 * (m & 3);
    unsigned selk[4];
#pragma unroll
    for (int k = 0; k < 4; ++k) selk[k] = (0x0c0c0c0cu & ~(0xffu << sh)) | ((unsigned)k << sh);
    const int M0 = (m >> 2) == 0 ? -1 : 0, M1 = (m >> 2) == 1 ? -1 : 0, M2 = (m >> 2) == 2 ? -1 : 0, M3 = (m >> 2) == 3 ? -1 : 0;
    const int clo = slice * 256 + cq * 32 + ((q & 1) * 4 + (q >> 1) * 16), chi = clo + 8;
    const int tstep = 2 * gr.gsize * NWAVES; int t = par + 2 * (gr.gidx * NWAVES + wave);
    if (t >= T) return;
    int idn[16]; v4u rr[16]; v4u c0w, c1w;
    p8_ids(ws, t, ug, idn); p8_rows(tab, toff, idn, rr);
    { const v4u* C8 = (const v4u*)(ws + WS_C8 + (size_t)t * 128) + 2 * q; c0w = C8[0]; c1w = C8[1]; }
    p8_ids(ws, t + tstep, ug, idn);
    for (; t < T; t += tstep) {
        const int t1 = t + tstep;
        int id2[16]; p8_ids(ws, t + 2 * tstep, ug, id2);
        const v4u* C81 = (const v4u*)(ws + WS_C8 + (size_t)(t1 < T ? t1 : T - 1) * 128) + 2 * q; const v4u c0n = C81[0], c1n = C81[1];
        const unsigned cb0[4] = {c0w.x, c0w.y, c0w.z, c0w.w}, cb1[4] = {c1w.x, c1w.y, c1w.z, c1w.w};
        const float csc = ((const float*)(ws + WS_CSC))[t], cs8 = ((const float*)(ws + WS_CSC))[T + t];
        const bf16* hb = (const bf16*)(ws + WS_HB) + (size_t)t * DM;
        const v2u hwl = __builtin_nontemporal_load((const v2u*)(hb + clo)), hwh = __builtin_nontemporal_load((const v2u*)(hb + chi));
        v4i aL0 = {0, 0, 0, 0}, aL1 = {0, 0, 0, 0}, aH0 = {0, 0, 0, 0}, aH1 = {0, 0, 0, 0};
#pragma unroll
        for (int i = 0; i < 16; ++i) {
            const int v0 = (int)__builtin_amdgcn_perm(0u, cb0[i >> 2], selk[i & 3]), v1 = (int)__builtin_amdgcn_perm(0u, cb1[i >> 2], selk[i & 3]);
            const v4i a0 = {v0 & M0, v0 & M1, v0 & M2, v0 & M3}, a1 = {v1 & M0, v1 & M1, v1 & M2, v1 & M3};
            const v4i bl = {(int)(rr[i].x & 0x0f0f0f0fu), (int)(rr[i].y & 0x0f0f0f0fu), (int)(rr[i].z & 0x0f0f0f0fu), (int)(rr[i].w & 0x0f0f0f0fu)};
            const v4i bh = {(int)rr[i].x, (int)rr[i].y, (int)rr[i].z, (int)rr[i].w};
            aL0 = __builtin_amdgcn_mfma_i32_16x16x64_i8(a0, bl, aL0, 0, 0, 0); aL1 = __builtin_amdgcn_mfma_i32_16x16x64_i8(a1, bl, aL1, 0, 0, 0);
            aH0 = __builtin_amdgcn_mfma_i32_16x16x64_i8(a0, bh, aH0, 0, 0, 0); aH1 = __builtin_amdgcn_mfma_i32_16x16x64_i8(a1, bh, aH1, 0, 0, 0);
            rr[i] = *(const v4u*)(tab + ((unsigned)idn[i] * 128u + toff));
            idn[i] = id2[i];
            asm volatile("" : "+v"(aL0), "+v"(aL1), "+v"(aH0), "+v"(aH1) :: "memory");
            __builtin_amdgcn_sched_barrier(0);
        }
        c0w = c0n; c1w = c1n;
        int vl[4], vh[4];
#pragma unroll
        for (int r = 0; r < 4; ++r) { const int a = (m < 8) ? aL0[r] : aL1[r]; vl[r] = a + dpp_ror8i(a); const int b = (m < 8) ? aH0[r] : aH1[r]; vh[r] = b + dpp_ror8i(b); }
        if (m < 8) {
            f32x4 ol, oh;
            ol[0] = bflo(hwl.x) + ((float)vl[0] - cs8) * csc; ol[1] = bfhi(hwl.x) + ((float)vl[1] - cs8) * csc; ol[2] = bflo(hwl.y) + ((float)vl[2] - cs8) * csc; ol[3] = bfhi(hwl.y) + ((float)vl[3] - cs8) * csc;
            oh[0] = bflo(hwh.x) + (float)((vh[0] - vl[0]) >> 4) * csc; oh[1] = bfhi(hwh.x) + (float)((vh[1] - vl[1]) >> 4) * csc; oh[2] = bflo(hwh.y) + (float)((vh[2] - vl[2]) >> 4) * csc; oh[3] = bfhi(hwh.y) + (float)((vh[3] - vl[3]) >> 4) * csc;
            __builtin_nontemporal_store(ol, (f32x4*)(P.out + (size_t)t * DM + clo)); __builtin_nontemporal_store(oh, (f32x4*)(P.out + (size_t)t * DM + chi));
        }
    }
}

#define XB_TMO      128
#define XB_XCNT(j)  (256  + 64 * (j))
#define XB_XSUB(j)  (1280 + 64 * (j))
#define XB_XGEN(j)  (2304 + 64 * (j))
#define XB_TOP      3328
#define XB_TOPGEN   3392
#define XCD_BAR_WORDS 3456
#define XB_SPIN_CAP (1u << 18)

__device__ __forceinline__ unsigned xb_ld(unsigned* p)              { return __hip_atomic_load(p, __ATOMIC_RELAXED, __HIP_MEMORY_SCOPE_AGENT); }
__device__ __forceinline__ unsigned xb_add(unsigned* p, unsigned v) { return __hip_atomic_fetch_add(p, v, __ATOMIC_RELAXED, __HIP_MEMORY_SCOPE_AGENT); }
__device__ __forceinline__ unsigned xb_xcc_id() { return (unsigned)__builtin_amdgcn_s_getreg((3 << 11) | 20) & 0xFu; }
#define XB_SPIN(cond, bar) do { unsigned _sp = 0; while (cond) { __builtin_amdgcn_s_sleep(1); \
    if ((++_sp & 255u) == 0u) { if (xb_ld(&(bar)[XB_TMO])) break; if (_sp > XB_SPIN_CAP) { atomicAdd(&(bar)[XB_TMO], 1u); break; } } } } while (0)

struct XcdBarrier {
    unsigned* bar; unsigned x;
    volatile LAS unsigned* st;
};

__device__ __forceinline__ XcdBarrier xcd_barrier_post(unsigned* bar, volatile LAS unsigned* st) {
    XcdBarrier b; b.bar = bar; b.x = xb_xcc_id(); b.st = st;
    if (threadIdx.x == 0) (void)xb_add(&bar[XB_XCNT(b.x)], 1u);
    return b;
}
__device__ __forceinline__ void xcd_barrier_complete(unsigned* bar, unsigned x, unsigned& nloc, unsigned& nx) {
    const unsigned G = gridDim.x * gridDim.y * gridDim.z;
    unsigned sum, cnt, mine, sp = 0u;
    for (;;) {
        sum = 0u; cnt = 0u; mine = 0u;
#pragma unroll
        for (unsigned j = 0; j < 16; ++j) { const unsigned c = xb_ld(&bar[XB_XCNT(j)]); sum += c; cnt += (c > 0u) ? 1u : 0u; mine = (j == x) ? c : mine; }
        if (sum == G) break;
        __builtin_amdgcn_s_sleep(1);
        if ((++sp & 255u) == 0u) { if (xb_ld(&bar[XB_TMO])) break; if (sp > XB_SPIN_CAP) { atomicAdd(&bar[XB_TMO], 1u); break; } }
    }
    nloc = mine > 0u ? mine : 1u; nx = cnt > 0u ? cnt : 1u;
}

__device__ __forceinline__ void xcd_barrier(const XcdBarrier& b) {
    asm volatile("s_waitcnt vmcnt(0)" ::: "memory");
    __syncthreads();
    if (threadIdx.x == 0) {
        unsigned* bar = b.bar;
        __builtin_amdgcn_s_waitcnt(0);
        unsigned nloc = b.st[0], nx = b.st[1];
        if (nloc == 0u) { xcd_barrier_complete(bar, b.x, nloc, nx); b.st[0] = nloc; b.st[1] = nx; }
        const unsigned old = xb_add(&bar[XB_XSUB(b.x)], 1u);
        const unsigned gen = old / nloc;
        if (old + 1u == (gen + 1u) * nloc) {
            __builtin_amdgcn_fence(__ATOMIC_RELEASE, "agent");
            asm volatile("s_waitcnt vmcnt(0)" ::: "memory");
            const unsigned og = xb_add(&bar[XB_TOP], 1u);
            const unsigned tg = og / nx;
            if (og + 1u == (tg + 1u) * nx) xb_add(&bar[XB_TOPGEN], 1u);
            else XB_SPIN(xb_ld(&bar[XB_TOPGEN]) == tg, bar);
            __builtin_amdgcn_fence(__ATOMIC_ACQUIRE, "agent");
            xb_add(&bar[XB_XGEN(b.x)], 1u);
            asm volatile("s_waitcnt vmcnt(0)" ::: "memory");
        } else {
            XB_SPIN(xb_ld(&bar[XB_XGEN(b.x)]) == gen, bar);
            __builtin_amdgcn_fence(__ATOMIC_ACQUIRE, "agent");
            asm volatile("s_waitcnt vmcnt(0)" ::: "memory");
        }
    }
    __syncthreads();
}

__global__ void __launch_bounds__(NTHR, 2) hymba_fwd(Ptrs P) {
    extern __shared__ __attribute__((aligned(16))) unsigned char lds_raw[];
    LAS unsigned char* lds = (LAS unsigned char*)lds_raw;
    const int tid = threadIdx.x;
    const int G = gridDim.x, bx = blockIdx.x, vcu = (G % 8 == 0) ? (bx % 8) * (G / 8) + bx / 8 : bx;
    unsigned char* ws = P.ws;
    if (tid < 64) ((LAS unsigned*)(lds + LDSCTL_OFF))[tid] = 0u;
    __syncthreads();
    XcdBarrier bar = xcd_barrier_post((unsigned*)(ws + WS_CTL) + CW_BAR, (volatile LAS unsigned*)(lds + LDSCTL_OFF));

    p0_wmax(P, vcu, G);
    __syncthreads();
    if (tid == 0) (void)__hip_atomic_fetch_add((unsigned*)(ws + WS_CTL) + CW_WCNT, 1u, __ATOMIC_RELEASE, __HIP_MEMORY_SCOPE_AGENT);
    p0_stream(P, lds, vcu, G);
    if (tid == 0) { XB_SPIN(xb_ld((unsigned*)(ws + WS_CTL) + CW_WCNT) < (unsigned)G, bar.bar); (void)__hip_atomic_load((unsigned*)(ws + WS_CTL) + CW_WCNT, __ATOMIC_ACQUIRE, __HIP_MEMORY_SCOPE_AGENT); }
    __syncthreads();
    p0_weights(P, lds, vcu, G);
    xcd_barrier(bar);

    {
        const int n1 = (G == 256) ? P1_COLS : INW_MAIN;
        pg8::Gemm g{(const pg8::bf16_t*)(ws + WS_XA8), (const pg8::bf16_t*)(ws + WS_WIN), T, n1, DM / 2}; pg8::StaticOrder S; S.init(T, n1, G, bx);
        pg8::EpiProj E{(pg8::bf16_t*)(ws + WS_AQ), (pg8::bf16_t*)(ws + WS_AK), (pg8::bf16_t*)(ws + WS_AV), (pg8::bf16_t*)(ws + WS_MQ), (pg8::bf16_t*)(ws + WS_MK), (pg8::bf16_t*)(ws + WS_MV), (pg8::bf16_t*)(ws + WS_MO), (const float*)(ws + WS_SA), __builtin_bit_cast(float, __hip_atomic_load((unsigned*)(ws + WS_CTL) + CW_WMAX, __ATOMIC_RELAXED, __HIP_MEMORY_SCOPE_AGENT)) * (1.0f / 127.0f), 0};
        pg8::gemm_phase<pg8::EpiProj, pg8::StaticOrder, true, false, false, true>(lds, g, S, E);
    }
    xcd_barrier(bar);

    if (G == 256) {
        { pg8::Gemm g2{(const pg8::bf16_t*)(ws + WS_XA8), (const pg8::bf16_t*)(ws + WS_WIN + (size_t)P1_COLS * DM), T, INW_MAIN - P1_COLS, DM / 2}; pg8::StaticOrder S2; S2.init(T, INW_MAIN - P1_COLS, G, bx);
          pg8::EpiProj E2{(pg8::bf16_t*)(ws + WS_AQ), (pg8::bf16_t*)(ws + WS_AK), (pg8::bf16_t*)(ws + WS_AV), (pg8::bf16_t*)(ws + WS_MQ), (pg8::bf16_t*)(ws + WS_MK), (pg8::bf16_t*)(ws + WS_MV), (pg8::bf16_t*)(ws + WS_MO), (const float*)(ws + WS_SA), __builtin_bit_cast(float, __hip_atomic_load((unsigned*)(ws + WS_CTL) + CW_WMAX, __ATOMIC_RELAXED, __HIP_MEMORY_SCOPE_AGENT)) * (1.0f / 127.0f), P1_COLS / 256};
          pg8::gemm_phase<pg8::EpiProj, pg8::StaticOrder, true, false, false, true>(lds, g2, S2, E2); }
        __syncthreads();
    }
    {
    constexpr int NIT = BATCH * MLH * NCHUNK;
    const bool split = (G == 256);
    const int it0 = split ? (bx < 128 ? 640 + bx : bx - 128) : vcu, istep = split ? 128 : G, icnt = split ? (bx < 128 ? 3 : 5) : (vcu < NIT ? (NIT - vcu + G - 1) / G : 0);
    for (int k = 0; k < icnt; ++k) p2_mlstm_item(P, lds, it0 + istep * k);
    p2_rows(P, vcu, G); p2_vt(P, vcu, G); }
    xcd_barrier(bar);

    p3_scan(P, lds, vcu, G);
    {
        const attn_body::AttnTensors AT{(const attn_body::bf16*)(ws + WS_AQ), (const unsigned char*)(ws + WS_AK8), (const unsigned char*)(ws + WS_AV8T), ws + WS_MIX, P.att_q_gain, P.att_k_gain};
        const attn_body::StaticOrder S(G, bx);
        __syncthreads();
        attn_body::attn_phase<attn_body::StaticOrder>((char*)lds_raw, AT, S);
    }
    xcd_barrier(bar);

    for (int item = vcu; item < BATCH * MLH * NCHUNK; item += G) p4_mlstm_item(P, lds, item);
    xcd_barrier(bar);

    {
        pg8::Gemm g{(const pg8::bf16_t*)(ws + WS_MIX), (const pg8::bf16_t*)(ws + WS_WOUT), T, DM, DM / 2}; pg8::StaticOrder S; S.init(T, DM, G, bx);
        pg8::EpiRes E{(const unsigned char*)(ws + WS_XA8), (const float*)(ws + WS_SA), (const float*)(ws + WS_RR), (pg8::bf16_t*)(ws + WS_HB), (float*)(ws + WS_SSQ), 1.0f / (W8SCALE * MIX8SCALE)};
        pg8::gemm_phase<pg8::EpiRes, pg8::StaticOrder, true, false, true>(lds, g, S, E);
    }
    xcd_barrier(bar);

    {
        pg8::Gemm g{(const pg8::bf16_t*)(ws + WS_HB), (const pg8::bf16_t*)(ws + WS_WEFF), T, 2048, DM}; pg8::StaticOrder S; S.init(T, 2048, G, bx);
        pg8::EpiScore E{(const float*)(ws + WS_SSQ), (unsigned short*)(ws + WS_SC), NORM_EPS};
        pg8::gemm_phase<pg8::EpiScore, pg8::StaticOrder, true, true>(lds, g, S, E);
    }
    xcd_barrier(bar);

    p7_topk(P, lds, vcu, G);
    xcd_barrier(bar);

    p8a_down(P, vcu, G);
    xcd_barrier(bar);
    p8b_act(P, vcu, G);
    xcd_barrier(bar);
    p8c_up(P, vcu, G);
}

extern "C" void kernel_launch(void* const* d_in, const int* in_sizes, int n_in, void* d_out, int out_size, void* d_ws, size_t ws_size, hipStream_t stream) {
    static int grid = 0;
    if (grid == 0) {
        if (n_in != 16 || in_sizes[0] != T * DM || out_size != T * DM || ws_size < WS_END) { fprintf(stderr, "kernel_launch: unexpected shapes (n_in %d, in0 %d, out %d, ws %zu); nothing launched\n", n_in, n_in > 0 ? in_sizes[0] : -1, out_size, ws_size); grid = -1; return; }
        int dev = 0, cus = 0, per_cu = 0;
        if (hipGetDevice(&dev) != hipSuccess || hipDeviceGetAttribute(&cus, hipDeviceAttributeMultiprocessorCount, dev) != hipSuccess) { grid = -1; return; }
        if (hipFuncSetAttribute((const void*)hymba_fwd, hipFuncAttributeMaxDynamicSharedMemorySize, LDS_BYTES) != hipSuccess) { fprintf(stderr, "kernel_launch: hipFuncSetAttribute failed\n"); grid = -1; return; }
        if (hipOccupancyMaxActiveBlocksPerMultiprocessor(&per_cu, (const void*)hymba_fwd, NTHR, LDS_BYTES) != hipSuccess || per_cu < 1) { fprintf(stderr, "kernel_launch: occupancy query reports %d workgroups per CU; nothing launched\n", per_cu); (void)hipGetLastError(); grid = -1; return; }
        grid = cus;
    }
    if (grid < 0) return;
    static_assert((size_t)(CW_BAR + XCD_BAR_WORDS) * 4 <= CTL_ZERO_BYTES && (size_t)(CW_WCNT + 1) * 4 <= CTL_ZERO_BYTES, "control words outside the zeroed range");
    if (hipMemsetAsync((char*)d_ws + WS_CTL, 0, CTL_ZERO_BYTES, stream) != hipSuccess) return;
    Ptrs p{};
    p.x = (const float*)d_in[0]; p.norm1_gain = (const float*)d_in[1]; p.w_in = (const float*)d_in[2]; p.att_q_gain = (const float*)d_in[3]; p.att_k_gain = (const float*)d_in[4];
    p.ml_conv_w = (const float*)d_in[5]; p.ml_conv_b = (const float*)d_in[6]; p.ml_igate_bias = (const float*)d_in[7]; p.ml_fgate_bias = (const float*)d_in[8]; p.ml_out_gain = (const float*)d_in[9];
    p.w_out = (const float*)d_in[10]; p.norm2_gain = (const float*)d_in[11]; p.peer_w_query = (const float*)d_in[12]; p.peer_sub_keys = (const float*)d_in[13]; p.peer_down = (const float*)d_in[14]; p.peer_up = (const float*)d_in[15];
    p.out = (float*)d_out; p.ws = (unsigned char*)d_ws;
    hipLaunchKernelGGL(hymba_fwd, dim3(grid), dim3(NTHR), LDS_BYTES, stream, p);
}
```
